# Optimizing an MI355X kernel written in HIP

```python
import jax
import jax.numpy as jnp
from jax import lax
import numpy as np

D_MODEL = 1024
BATCH = 8
SEQ = 2048
DEPTH = 1

CTX_LEN = 256
GRID_W = 64
N_MOD = 6
EPS = 1e-6

LRU_WIDTH = 1024
LRU_BLOCKS = 8
LRU_BLOCK = LRU_WIDTH // LRU_BLOCKS
CONV_WIDTH = 4
CONV_LEFT = 2
LRU_C = 8.0

HG_HEADS = 8
HG_DK = 128
HG_DV = 128
HG_QK_WIDTH = HG_HEADS * HG_DK
HG_V_WIDTH = HG_HEADS * HG_DV
HG_CHUNK = 64

N_EXPERTS = 32
TOP_K = 4
D_FF = 1024
SWIGLU_LIMIT = 7.0
SWIGLU_ALPHA = 1.702
MOE_BLOCK = 128

IN_SIZES = (LRU_WIDTH, LRU_WIDTH, HG_QK_WIDTH, HG_QK_WIDTH, HG_QK_WIDTH, HG_V_WIDTH, HG_V_WIDTH, D_MODEL, D_MODEL)
IN_COLS = sum(IN_SIZES)

kernel_name = "hybrid_rglru_hgrn2_moe_dit_block"


def rms_norm(x, g):
    xf = x.astype(jnp.float32)
    y = xf * lax.rsqrt(jnp.mean(xf * xf, axis=-1, keepdims=True) + EPS)
    return (y * g.astype(jnp.float32)).astype(x.dtype)


def split_in(p):
    offs = np.cumsum(IN_SIZES)[:-1].tolist()
    return jnp.split(p, offs, axis=-1)


def split_heads(t):
    return t.reshape(t.shape[0], t.shape[1], HG_HEADS, t.shape[2] // HG_HEADS)


def short_conv(u, w, b, row_len):
    L = u.shape[1]
    up = jnp.pad(u, ((0, 0), (CONV_LEFT, CONV_WIDTH - 1 - CONV_LEFT), (0, 0)))
    col = jnp.arange(L) % row_len
    out = b
    for k in range(CONV_WIDTH):
        d = k - CONV_LEFT
        valid = ((col + d >= 0) & (col + d < row_len))[None, :, None]
        out = out + jnp.where(valid, up[:, k:k + L], 0) * w[k]
    return out


def linear_scan(a, b, h0, reverse):
    if reverse:
        a, b = a[:, ::-1], b[:, ::-1]
    b = b.at[:, 0].add(a[:, 0] * h0)
    _, h = lax.associative_scan(lambda l, r: (l[0] * r[0], r[0] * l[1] + r[1]), (a, b), axis=1)
    h_last = h[:, -1]
    if reverse:
        h = h[:, ::-1]
    return h, h_last


def rglru_direction(u, h0, wa, ba, wx, bx, lam, reverse):
    B, L, W = u.shape
    ub = u.reshape(B, L, LRU_BLOCKS, LRU_BLOCK)
    r = jax.nn.sigmoid(jnp.einsum("blgi,gij->blgj", ub, wa) + ba).reshape(B, L, W)
    i = jax.nn.sigmoid(jnp.einsum("blgi,gij->blgj", ub, wx) + bx).reshape(B, L, W)
    log_a = -LRU_C * r * jax.nn.softplus(-lam)
    a = jnp.exp(log_a)
    mult = jnp.sqrt(-jnp.expm1(2.0 * log_a))
    return linear_scan(a, mult * (i * u), h0, reverse)


def rglru_mixer(ax_c, ax_l, conv_w, conv_b, wa, ba, wx, bx, lam):
    u_c = short_conv(ax_c, conv_w, conv_b, ax_c.shape[1])
    u_l = short_conv(ax_l, conv_w, conv_b, GRID_W)
    h0 = jnp.zeros((u_c.shape[0], LRU_WIDTH), u_c.dtype)
    y_c, y_l = [], []
    for d in range(2):
        rev = d == 1
        hc, hc_last = rglru_direction(u_c, h0, wa[d], ba[d], wx[d], bx[d], lam[d], rev)
        hl, _ = rglru_direction(u_l, hc_last, wa[d], ba[d], wx[d], bx[d], lam[d], rev)
        y_c.append(hc)
        y_l.append(hl)
    return y_c[0] + y_c[1], y_l[0] + y_l[1]


def hgrn2_chunk_scan(q, logf, k, v, s0, reverse):
    if reverse:
        q, logf, k, v = (t[:, ::-1] for t in (q, logf, k, v))
    B, L, H, _ = q.shape
    n_chunks = L // HG_CHUNK
    q, logf, k, v = (t.reshape(B, n_chunks, HG_CHUNK, H, t.shape[-1]) for t in (q, logf, k, v))
    g_cum = jnp.cumsum(logf, axis=2)
    g_mid = g_cum[:, :, HG_CHUNK // 2 - 1:HG_CHUNK // 2]
    g_end = g_cum[:, :, -1]
    scores = jnp.einsum("bnthd,bnshd->bnhts", q * jnp.exp(g_cum - g_mid), k * jnp.exp(g_mid - g_cum))
    lower_tri = jnp.tril(jnp.ones((HG_CHUNK, HG_CHUNK), bool))
    scores = jnp.where(lower_tri, scores, 0)
    o_intra = jnp.einsum("bnhts,bnshe->bnthe", scores, v)
    upd = jnp.einsum("bnshd,bnshe->bnhde", k * jnp.exp(g_end[:, :, None] - g_cum), v)
    decay = jnp.exp(g_end)

    def step(s, inp):
        dec, u = inp
        return dec[..., None] * s + u, s

    s_last, s_prev = lax.scan(step, s0, (jnp.moveaxis(decay, 1, 0), jnp.moveaxis(upd, 1, 0)))
    o_inter = jnp.einsum("bnthd,nbhde->bnthe", q * jnp.exp(g_cum), s_prev)
    o = (o_intra + o_inter).reshape(B, L, H, v.shape[-1])
    if reverse:
        o = o[:, ::-1]
    return o, s_last


def hgrn2_forget(f_raw, lb):
    f = lb + (1.0 - lb) * jax.nn.sigmoid(f_raw.astype(jnp.float32))
    return split_heads(jnp.log(f)), split_heads(1.0 - f)


def hgrn2_mixer(p_c, p_l, lb, norm_g):
    q_c, ff_c, fb_c, i_c, g_c = p_c
    q_l, ff_l, fb_l, i_l, g_l = p_l
    qh_c, vh_c = split_heads(jax.nn.silu(q_c)), split_heads(i_c)
    qh_l, vh_l = split_heads(jax.nn.silu(q_l)), split_heads(i_l)
    s0 = jnp.zeros((q_c.shape[0], HG_HEADS, HG_DK, HG_DV), jnp.float32)
    o_c, o_l = [], []
    for d, (f_c, f_l) in enumerate(((ff_c, ff_l), (fb_c, fb_l))):
        rev = d == 1
        logf_c, k_c = hgrn2_forget(f_c, lb)
        logf_l, k_l = hgrn2_forget(f_l, lb)
        oc, s_ctx = hgrn2_chunk_scan(qh_c, logf_c, k_c, vh_c, s0, rev)
        ol, _ = hgrn2_chunk_scan(qh_l, logf_l, k_l, vh_l, s_ctx, rev)
        o_c.append(oc)
        o_l.append(ol)

    def readout(o, g):
        y = rms_norm(o, norm_g) * jax.nn.silu(split_heads(g))
        return y.reshape(g.shape).astype(g.dtype)

    return readout(o_c[0] + o_c[1], g_c), readout(o_l[0] + o_l[1], g_l)


def moe(t, rw, rb, w1, b1, w2, b2):
    T, D = t.shape
    logits = (t @ rw + rb).astype(jnp.float32)
    top_val, top_idx = lax.top_k(logits, TOP_K)
    gates = jax.nn.softmax(top_val, axis=-1)
    n_assign = T * TOP_K
    e_flat = top_idx.reshape(n_assign)
    order = jnp.argsort(e_flat)
    e_sorted = e_flat[order]
    tok_sorted = (order // TOP_K).astype(jnp.int32)
    gate_sorted = gates.reshape(n_assign)[order]
    counts = jnp.bincount(e_flat, length=N_EXPERTS)
    padded = (counts + MOE_BLOCK - 1) // MOE_BLOCK * MOE_BLOCK
    start = jnp.cumsum(counts) - counts
    pend = jnp.cumsum(padded)
    pstart = pend - padded
    dest = pstart[e_sorted] + jnp.arange(n_assign) - start[e_sorted]
    n_blocks = -(-n_assign // MOE_BLOCK) + N_EXPERTS
    n_slots = n_blocks * MOE_BLOCK
    slot_tok = jnp.zeros((n_slots,), jnp.int32).at[dest].set(tok_sorted)
    slot_gate = jnp.zeros((n_slots,), jnp.float32).at[dest].set(gate_sorted)
    block_start = jnp.arange(n_blocks) * MOE_BLOCK
    block_expert = jnp.minimum(jnp.sum(block_start[:, None] >= pend[None, :], axis=1), N_EXPERTS - 1)

    def expert_block(args):
        tok, e = args
        h = t[tok] @ w1[e] + b1[e]
        hg = jnp.minimum(h[:, 0::2], SWIGLU_LIMIT)
        hu = jnp.clip(h[:, 1::2], -SWIGLU_LIMIT, SWIGLU_LIMIT)
        act = hg * jax.nn.sigmoid(SWIGLU_ALPHA * hg) * (hu + 1)
        return act @ w2[e] + b2[e]

    y = lax.map(expert_block, (slot_tok.reshape(n_blocks, MOE_BLOCK), block_expert))
    y = y.reshape(n_slots, D) * slot_gate[:, None].astype(t.dtype)
    return jnp.zeros_like(t).at[slot_tok].add(y)


def mixer_sublayer(x, xc, mod_l, mod_c, norm_g, w_in, conv_w, conv_b, wa, ba, wx, bx, lam,
                   lb, hg_norm_g, w_ba, w_bb, w_out, update_ctx):
    h_l = rms_norm(x, norm_g) * (1 + mod_l[1]) + mod_l[0]
    h_c = rms_norm(xc, norm_g) * (1 + mod_c[1]) + mod_c[0]
    ax_l, ag_l, q_l, ff_l, fb_l, i_l, g_l, ma_l, mb_l = split_in(h_l @ w_in)
    ax_c, ag_c, q_c, ff_c, fb_c, i_c, g_c, ma_c, mb_c = split_in(h_c @ w_in)
    ya_c, ya_l = rglru_mixer(ax_c, ax_l, conv_w, conv_b, wa, ba, wx, bx, lam)
    yb_c, yb_l = hgrn2_mixer((q_c, ff_c, fb_c, i_c, g_c), (q_l, ff_l, fb_l, i_l, g_l), lb, hg_norm_g)

    def merge(ya, a_gate, yb, ma, mb):
        za = (ya * jax.nn.gelu(a_gate)) @ w_ba
        zb = yb @ w_bb
        return (jax.nn.sigmoid(ma) * za + jax.nn.sigmoid(mb) * zb) @ w_out

    x = x + mod_l[2] * merge(ya_l, ag_l, yb_l, ma_l, mb_l)
    if update_ctx:
        xc = xc + mod_c[2] * merge(ya_c, ag_c, yb_c, ma_c, mb_c)
    return x, xc


def moe_sublayer(x, xc, mod_l, mod_c, norm_g, rw, rb, w1, b1, w2, b2, update_ctx):
    h_l = (rms_norm(x, norm_g) * (1 + mod_l[4]) + mod_l[3]).reshape(-1, D_MODEL)
    if update_ctx:
        h_c = (rms_norm(xc, norm_g) * (1 + mod_c[4]) + mod_c[3]).reshape(-1, D_MODEL)
        y = moe(jnp.concatenate([h_l, h_c], axis=0), rw, rb, w1, b1, w2, b2)
        n_l = h_l.shape[0]
        x = x + mod_l[5] * y[:n_l].reshape(x.shape)
        xc = xc + mod_c[5] * y[n_l:].reshape(xc.shape)
    else:
        x = x + mod_l[5] * moe(h_l, rw, rb, w1, b1, w2, b2).reshape(x.shape)
    return x, xc


def setup_inputs(seed: int = 0) -> dict:
    key = jax.random.key(seed)
    ks = jax.random.split(key, 32)
    D = D_MODEL

    def nrm(k, shape, scale):
        return jax.random.normal(k, shape, jnp.float32) * scale

    lam_u = jax.random.uniform(ks[14], (DEPTH, 2, LRU_WIDTH), jnp.float32, 0.9, 0.999)
    a_base = lam_u ** (1.0 / LRU_C)
    lru_lam = jnp.log(a_base) - jnp.log1p(-a_base)
    return {
        "x": nrm(ks[0], (BATCH, SEQ, D), 1.0),
        "c": nrm(ks[1], (BATCH, D), 1.0),
        "ctx": nrm(ks[2], (BATCH, CTX_LEN, D), 1.0),
        "c_ctx": nrm(ks[3], (D,), 1.0),
        "ada_w": nrm(ks[4], (DEPTH, D, N_MOD * D), 0.5 * D ** -0.5),
        "ada_b": nrm(ks[5], (DEPTH, N_MOD * D), 0.01),
        "norm1_g": 1.0 + nrm(ks[6], (DEPTH, D), 0.01),
        "norm2_g": 1.0 + nrm(ks[7], (DEPTH, D), 0.01),
        "w_in": nrm(ks[8], (DEPTH, D, IN_COLS), D ** -0.5),
        "lru_conv_w": nrm(ks[9], (DEPTH, CONV_WIDTH, LRU_WIDTH), CONV_WIDTH ** -0.5),
        "lru_conv_b": nrm(ks[10], (DEPTH, LRU_WIDTH), 0.01),
        "lru_wa": nrm(ks[11], (DEPTH, 2, LRU_BLOCKS, LRU_BLOCK, LRU_BLOCK), LRU_BLOCK ** -0.5),
        "lru_ba": nrm(ks[12], (DEPTH, 2, LRU_BLOCKS, LRU_BLOCK), 0.01),
        "lru_wx": nrm(ks[13], (DEPTH, 2, LRU_BLOCKS, LRU_BLOCK, LRU_BLOCK), LRU_BLOCK ** -0.5),
        "lru_bx": nrm(ks[15], (DEPTH, 2, LRU_BLOCKS, LRU_BLOCK), 0.01),
        "lru_lam": lru_lam,
        "hg_lb_logits": nrm(ks[16], (DEPTH + 1, HG_QK_WIDTH), 0.1),
        "hg_norm_g": 1.0 + nrm(ks[17], (DEPTH, HG_DV), 0.01),
        "w_branch_a": nrm(ks[18], (DEPTH, LRU_WIDTH, D), LRU_WIDTH ** -0.5),
        "w_branch_b": nrm(ks[19], (DEPTH, HG_V_WIDTH, D), HG_V_WIDTH ** -0.5),
        "w_out": nrm(ks[20], (DEPTH, D, D), D ** -0.5),
        "router_w": nrm(ks[21], (DEPTH, D, N_EXPERTS), D ** -0.5),
        "router_b": nrm(ks[22], (DEPTH, N_EXPERTS), 0.01),
        "moe_w1": nrm(ks[23], (DEPTH, N_EXPERTS, D, 2 * D_FF), D ** -0.5),
        "moe_b1": nrm(ks[24], (DEPTH, N_EXPERTS, 2 * D_FF), 0.01),
        "moe_w2": nrm(ks[25], (DEPTH, N_EXPERTS, D_FF, D), D_FF ** -0.5),
        "moe_b2": nrm(ks[26], (DEPTH, N_EXPERTS, D), 0.01),
        "final_g": 1.0 + nrm(ks[27], (D,), 0.01),
    }


def reference(x, c, ctx, c_ctx, ada_w, ada_b, norm1_g, norm2_g, w_in, lru_conv_w, lru_conv_b,
              lru_wa, lru_ba, lru_wx, lru_bx, lru_lam, hg_lb_logits, hg_norm_g, w_branch_a,
              w_branch_b, w_out, router_w, router_b, moe_w1, moe_b1, moe_w2, moe_b2, final_g):
    B = x.shape[0]
    lb_all = jnp.cumsum(jax.nn.softmax(hg_lb_logits.astype(jnp.float32), axis=0), axis=0)
    xc = ctx
    for layer in range(DEPTH):
        update_ctx = layer < DEPTH - 1
        mod_l = (jax.nn.silu(c) @ ada_w[layer] + ada_b[layer]).reshape(B, N_MOD, D_MODEL)
        mod_l = jnp.transpose(mod_l, (1, 0, 2))[:, :, None, :]
        mod_c = (jax.nn.silu(c_ctx) @ ada_w[layer] + ada_b[layer]).reshape(N_MOD, D_MODEL)[:, None, None, :]
        x, xc = mixer_sublayer(x, xc, mod_l, mod_c, norm1_g[layer], w_in[layer],
                               lru_conv_w[layer], lru_conv_b[layer], lru_wa[layer], lru_ba[layer],
                               lru_wx[layer], lru_bx[layer], lru_lam[layer], lb_all[layer],
                               hg_norm_g[layer], w_branch_a[layer], w_branch_b[layer], w_out[layer],
                               update_ctx)
        x, xc = moe_sublayer(x, xc, mod_l, mod_c, norm2_g[layer], router_w[layer], router_b[layer],
                             moe_w1[layer], moe_b1[layer], moe_w2[layer], moe_b2[layer], update_ctx)
    return rms_norm(x, final_g)
```

```cpp
#include <hip/hip_runtime.h>
#include <cstdio>
#include <cstdint>

#ifndef MK_N_LAUNCHES
#define MK_N_LAUNCHES 1
#endif

#define GAS __attribute__((address_space(1)))
#define LAS __attribute__((address_space(3)))
typedef unsigned short bf16;
typedef short bf16x8 __attribute__((ext_vector_type(8)));
typedef float f32x4 __attribute__((ext_vector_type(4)));
typedef float f32x2 __attribute__((ext_vector_type(2)));
typedef unsigned u32x4 __attribute__((ext_vector_type(4)));
typedef unsigned u32x2 __attribute__((ext_vector_type(2)));
typedef int i32x4 __attribute__((ext_vector_type(4)));

constexpr int NB = 8, SEQ = 2048, CTXL = 256, D = 1024;
constexpr int TL = NB * SEQ;
constexpr int TC = NB * CTXL;
constexpr int TT = TL + TC;
constexpr int NMOD = 6 * D;
constexpr int NE = 32;
constexpr float EPS = 1e-6f;
constexpr int NPH = 13;
constexpr int NWAVES = 8;

constexpr size_t MiB = 1u << 20;
constexpr size_t WS_CTL = 0, CTL_ZERO_BYTES = 1 * MiB;
constexpr size_t WS_MOD = 1 * MiB;
constexpr size_t WS_SPL = 1 * MiB + 512 * 1024;
constexpr size_t WS_ROUTE = 2 * MiB;
constexpr size_t WS_LIST = 3 * MiB;
constexpr size_t WS_AGG = 5 * MiB;
constexpr size_t WS_LRUW = 10 * MiB;
constexpr size_t WS_WBA = 12 * MiB, WS_WBB = 14 * MiB, WS_WOUT = 16 * MiB;
constexpr size_t WS_WIN = 18 * MiB;
constexpr size_t WS_W1 = 36 * MiB;
constexpr size_t WS_W2 = 164 * MiB;
constexpr size_t WS_H = 228 * MiB;
constexpr size_t WS_HS = 248 * MiB;
constexpr size_t WS_WINS = 30 * MiB;
constexpr size_t WS_P = 264 * MiB;
constexpr size_t PG_STRIDE = (size_t)TT * D;
constexpr size_t WS_A1 = 588 * MiB, WS_OF = 620 * MiB, WS_OB = 652 * MiB, WS_A2 = 684 * MiB, WS_T1 = 716 * MiB, WS_MM = 748 * MiB;
constexpr size_t WS_X1 = 780 * MiB;
constexpr size_t WS_H2 = 844 * MiB;
constexpr size_t WS_H2S = 864 * MiB;
constexpr size_t WS_SCL = 32 * MiB;
constexpr size_t WS_SW1 = 1 * MiB + 768 * 1024;
constexpr size_t WS_END = 876 * MiB;
constexpr size_t WS_ACT = WS_P;
constexpr size_t WS_Y = WS_P + 160 * MiB;
static_assert(WS_Y + (size_t)73728 * 1024 * 2 <= WS_A1, "overlay");
constexpr int CW_BAR = 4096;
constexpr int CW_CNT = 16384;

constexpr int RING_BYTES = 131072;
constexpr int SCLZ_OFF = 139264;
constexpr int GROW_OFF = 131072;
constexpr int LDS_MISC = 150528;
constexpr int LDS_BYTES = 151552;

#define LDS_WAIT() asm volatile("s_waitcnt lgkmcnt(0)" ::: "memory")
#define VM_WAIT() asm volatile("s_waitcnt vmcnt(0)" ::: "memory")

__device__ __forceinline__ float bf2f(unsigned b) { return __uint_as_float(b << 16); }
__device__ __forceinline__ float bflo(unsigned w) { return __uint_as_float(w << 16); }
__device__ __forceinline__ float bfhi(unsigned w) { return __uint_as_float(w & 0xffff0000u); }
typedef __bf16 nbf16x2 __attribute__((ext_vector_type(2)));
__device__ __forceinline__ unsigned f2bf(float f) { return (unsigned)__builtin_bit_cast(unsigned short, (__bf16)f); }
__device__ __forceinline__ unsigned pkbf(float lo, float hi) { nbf16x2 v; v[0] = (__bf16)lo; v[1] = (__bf16)hi; return __builtin_bit_cast(unsigned, v); }
__device__ __forceinline__ unsigned pk2(float lo, float hi) { return pkbf(lo, hi); }
__device__ __forceinline__ float wave_sum(float v) {
#pragma unroll
    for (int o = 1; o < 64; o <<= 1) v += __shfl_xor(v, o);
    return v;
}
__device__ __forceinline__ float fast_sigmoid(float z) { return __builtin_amdgcn_rcpf(1.0f + __builtin_amdgcn_exp2f(-1.44269504089f * z)); }

#define XB_TMO      128
#define XB_XCNT(j)  (256  + 64 * (j))
#define XB_XSUB(j)  (1280 + 64 * (j))
#define XB_XGEN(j)  (2304 + 64 * (j))
#define XB_TOP      3328
#define XB_TOPGEN   3392
#define XCD_BAR_WORDS 3456
#define XB_SPIN_CAP (1u << 18)

__device__ __forceinline__ unsigned xb_ld(unsigned* p)              { return __hip_atomic_load(p, __ATOMIC_RELAXED, __HIP_MEMORY_SCOPE_AGENT); }
__device__ __forceinline__ unsigned xb_add(unsigned* p, unsigned v) { return __hip_atomic_fetch_add(p, v, __ATOMIC_RELAXED, __HIP_MEMORY_SCOPE_AGENT); }
__device__ __forceinline__ unsigned xb_xcc_id() { return (unsigned)__builtin_amdgcn_s_getreg((3 << 11) | 20) & 0xFu; }
#define XB_SPIN(cond, bar) do { unsigned _sp = 0; while (cond) { __builtin_amdgcn_s_sleep(1); \
    if ((++_sp & 255u) == 0u) { if (xb_ld(&(bar)[XB_TMO])) break; if (_sp > XB_SPIN_CAP) { atomicAdd(&(bar)[XB_TMO], 1u); break; } } } } while (0)

struct XcdBarrier { unsigned* bar; unsigned x; volatile LAS unsigned* st; };

__device__ __forceinline__ XcdBarrier xcd_barrier_post(unsigned* bar, volatile LAS unsigned* st) {
    XcdBarrier b; b.bar = bar; b.x = xb_xcc_id(); b.st = st;
    if (threadIdx.x == 0) (void)xb_add(&bar[XB_XCNT(b.x)], 1u);
    return b;
}
__device__ __forceinline__ void xcd_barrier_complete(unsigned* bar, unsigned x, unsigned& nloc, unsigned& nx) {
    const unsigned G = gridDim.x * gridDim.y * gridDim.z;
    unsigned sum, cnt, mine, sp = 0u;
    for (;;) {
        sum = 0u; cnt = 0u; mine = 0u;
#pragma unroll
        for (unsigned j = 0; j < 16; ++j) { const unsigned c = xb_ld(&bar[XB_XCNT(j)]); sum += c; cnt += (c > 0u) ? 1u : 0u; mine = (j == x) ? c : mine; }
        if (sum == G) break;
        __builtin_amdgcn_s_sleep(1);
        if ((++sp & 255u) == 0u) { if (xb_ld(&bar[XB_TMO])) break; if (sp > XB_SPIN_CAP) { atomicAdd(&bar[XB_TMO], 1u); break; } }
    }
    nloc = mine > 0u ? mine : 1u; nx = cnt > 0u ? cnt : 1u;
}
__device__ __forceinline__ void xcd_barrier(const XcdBarrier& b) {
    asm volatile("s_waitcnt vmcnt(0)" ::: "memory");
    __syncthreads();
    if (threadIdx.x == 0) {
        unsigned* bar = b.bar;
        __builtin_amdgcn_s_waitcnt(0);
        unsigned nloc = b.st[0], nx = b.st[1];
        if (nloc == 0u) { xcd_barrier_complete(bar, b.x, nloc, nx); b.st[0] = nloc; b.st[1] = nx; }
        const unsigned old = xb_add(&bar[XB_XSUB(b.x)], 1u);
        const unsigned gen = old / nloc;
        if (old + 1u == (gen + 1u) * nloc) {
            __builtin_amdgcn_fence(__ATOMIC_RELEASE, "agent");
            asm volatile("s_waitcnt vmcnt(0)" ::: "memory");
            const unsigned og = xb_add(&bar[XB_TOP], 1u);
            const unsigned tg = og / nx;
            if (og + 1u == (tg + 1u) * nx) xb_add(&bar[XB_TOPGEN], 1u);
            else XB_SPIN(xb_ld(&bar[XB_TOPGEN]) == tg, bar);
            __builtin_amdgcn_fence(__ATOMIC_ACQUIRE, "agent");
            xb_add(&bar[XB_XGEN(b.x)], 1u);
            asm volatile("s_waitcnt vmcnt(0)" ::: "memory");
        } else {
            XB_SPIN(xb_ld(&bar[XB_XGEN(b.x)]) == gen, bar);
            __builtin_amdgcn_fence(__ATOMIC_ACQUIRE, "agent");
            asm volatile("s_waitcnt vmcnt(0)" ::: "memory");
        }
    }
    __syncthreads();
}

namespace pg8 {
constexpr int BM = 256, BK = 64, HALF = 128, HTB = HALF * BK * 2, STAGE_BYTES = 8 * HTB;
__host__ __device__ __forceinline__ int lds_byte(int r, int c) { const int st = (r >> 4) * 2 + (c >> 5), rr = r & 15, cc = c & 31, ob = rr * 64 + cc * 2; return st * 1024 + (ob ^ (((ob >> 9) & 1) << 5)); }
__host__ __device__ __forceinline__ void stage_rc(int b, int& R, int& C) { const int st = b / 1024, sb = b % 1024, swz = sb ^ (((sb >> 9) & 1) << 5); R = (st >> 1) * 16 + swz / 64; C = (st & 1) * 32 + (swz % 64) / 2; }
__host__ __device__ __forceinline__ int perm32(int rho) { const int n = rho >> 4, i = rho & 15; return 8 * (i >> 2) + 4 * n + (i & 3); }

struct Unit { const char* A; const char* B; int pm, pn, e, aux, idx; };

__device__ __forceinline__ unsigned cvt_pk_bf16(float lo, float hi) { unsigned r; asm volatile("v_cvt_pk_bf16_f32 %0, %1, %2" : "=v"(r) : "v"(lo), "v"(hi)); return r; }

__device__ __forceinline__ void rect_order(int wgid, int nM, int nN, int& pm, int& pn) {
    const int nwg = nM * nN; constexpr int NXCD = 8, WGM = 8;
    { const int q = nwg / NXCD, r = nwg % NXCD, xcd = wgid % NXCD, off = wgid / NXCD; wgid = (xcd < r ? xcd * (q + 1) : r * (q + 1) + (xcd - r) * q) + off; }
    const int nig = WGM * nN, gid = wgid / nig, fm = gid * WGM, gsz = (nM - fm) < WGM ? (nM - fm) : WGM;
    pm = fm + ((wgid % nig) % gsz); pn = (wgid % nig) / gsz;
}

template <bool I8> struct AccSel { typedef f32x4 type; };
template <> struct AccSel<true> { typedef i32x4 type; };
template <class Epi, class Sched, bool ALIGN_EPI, bool I8 = false>
__device__ __forceinline__ void gemm_phase(LAS unsigned char* lds, const int K, const Sched& S, const Epi& E) {
    typedef typename AccSel<I8>::type AccT;
    const int PB = I8 ? K : 2 * K;
    const int tid = threadIdx.x, wid = __builtin_amdgcn_readfirstlane(tid >> 6), lane = tid & 63, wr = wid >> 2, wc = wid & 3, fr = lane & 15, fq = lane >> 4;
    const int nt = PB / 128;
    int RA[2], CA[2]; unsigned voffB[2];
#pragma unroll
    for (int i = 0; i < 2; ++i) { int R, C; stage_rc(tid * 16 + i * 8192, R, C); const int Rb = Epi::PERM ? ((R & ~31) + perm32(R & 31)) : R;
        RA[i] = R; CA[i] = C; voffB[i] = (unsigned)(Rb * PB + C * 2); }
    const size_t kstep = 128;
    const size_t hstep = (size_t)HALF * PB;
    const unsigned ldsw = (unsigned)wid * 1024u;
    const int aoff = lds_byte(wr * 64 + fr, fq * 8), boff = lds_byte(wc * 32 + fr, fq * 8);
#define PG8_SA(b, h) (((b) * 2 + (h)) * HTB)
#define PG8_SB(b, h) ((4 + (b) * 2 + (h)) * HTB)
#define PG8_STAGE_B(bufoff, gbase) do { _Pragma("unroll") for (int _i = 0; _i < 2; ++_i) \
        __builtin_amdgcn_global_load_lds((const unsigned*)((const char*)(gbase) + voffB[_i]), (LAS unsigned*)(lds + (bufoff) + ldsw + _i * 8192), 16, 0, 0); } while (0)
#define PG8_STAGE_A(bufoff, gbase, o0, o1) do { \
        __builtin_amdgcn_global_load_lds((const unsigned*)((const char*)(gbase) + (o0)), (LAS unsigned*)(lds + (bufoff) + ldsw), 16, 0, 0); \
        __builtin_amdgcn_global_load_lds((const unsigned*)((const char*)(gbase) + (o1)), (LAS unsigned*)(lds + (bufoff) + ldsw + 8192), 16, 0, 0); } while (0)
#define PG8_LDA(dst, b, h) do { _Pragma("unroll") for (int m = 0; m < 4; ++m) _Pragma("unroll") for (int k = 0; k < 2; ++k) dst[m][k] = *(const LAS bf16x8*)(lds + PG8_SA(b, h) + aoff + m * 2048 + k * 1024); } while (0)
#define PG8_LDB(dst, b, h) do { _Pragma("unroll") for (int n = 0; n < 2; ++n) _Pragma("unroll") for (int k = 0; k < 2; ++k) dst[n][k] = *(const LAS bf16x8*)(lds + PG8_SB(b, h) + boff + n * 2048 + k * 1024); } while (0)
#define PG8_MMA(ai, bj, At, Bt) do { __builtin_amdgcn_s_setprio(1); _Pragma("unroll") for (int m = 0; m < 4; ++m) _Pragma("unroll") for (int n = 0; n < 2; ++n) _Pragma("unroll") for (int k = 0; k < 2; ++k) \
        { if constexpr (I8) acc[ai][bj][m][n] = __builtin_amdgcn_mfma_i32_16x16x64_i8(__builtin_bit_cast(i32x4, Bt[n][k]), __builtin_bit_cast(i32x4, At[m][k]), acc[ai][bj][m][n], 0, 0, 0); \
          else acc[ai][bj][m][n] = __builtin_amdgcn_mfma_f32_16x16x32_bf16(Bt[n][k], At[m][k], acc[ai][bj][m][n], 0, 0, 0); } __builtin_amdgcn_s_setprio(0); } while (0)
#define PG8_WAIT_V(n) asm volatile("s_waitcnt vmcnt(" #n ")" ::: "memory")
#define PG8_WAIT_L(n) asm volatile("s_waitcnt lgkmcnt(" #n ")" ::: "memory")
#define PG8_BAR __builtin_amdgcn_s_barrier()
#define PG8_SCHED __builtin_amdgcn_sched_barrier(0)
    Unit cur, nxt; int ui = 0;
    if (!S.next(0, cur)) return;
    AccT acc[2][2][4][2];
#pragma unroll
    for (int a = 0; a < 2; ++a)
#pragma unroll
        for (int b = 0; b < 2; ++b)
#pragma unroll
            for (int m = 0; m < 4; ++m)
#pragma unroll
                for (int n = 0; n < 2; ++n) acc[a][b][m][n] = (AccT){0, 0, 0, 0};
    bf16x8 At[4][2], B0[2][2], B1[2][2];
    unsigned c00, c01, c10, c11, n00, n01, n10, n11;
    if constexpr (Sched::GATHER) {
        S.arow4_issue(cur, RA[0], RA[1], 128 + RA[0], 128 + RA[1], c00, c01, c10, c11); S.arow4_finish(cur, RA[0], RA[1], 128 + RA[0], 128 + RA[1], CA[0] * 2u, CA[1] * 2u, c00, c01, c10, c11);
    } else {
        c00 = (unsigned)(RA[0] * PB + CA[0] * 2); c01 = (unsigned)(RA[1] * PB + CA[1] * 2); c10 = c00 + (unsigned)hstep; c11 = c01 + (unsigned)hstep;
    }
    n00 = c00; n01 = c01; n10 = c10; n11 = c11;
    const char* cA = cur.A; const char* cB = cur.B;
    PG8_STAGE_B(PG8_SB(0, 0), cB); PG8_STAGE_B(PG8_SB(0, 1), cB + hstep); PG8_STAGE_A(PG8_SA(0, 0), cA, c00, c01); PG8_STAGE_A(PG8_SA(0, 1), cA, c10, c11);
    if (wr == 1) PG8_BAR;
    PG8_WAIT_V(2); PG8_BAR;
    PG8_STAGE_B(PG8_SB(1, 0), cB + kstep); PG8_STAGE_A(PG8_SA(1, 0), cA + kstep, c00, c01); PG8_STAGE_B(PG8_SB(1, 1), cB + hstep + kstep);
    PG8_WAIT_V(6); PG8_BAR;
    for (;;) {
        const bool has_next = S.next(ui + 1, nxt);
        const char* nA = has_next ? nxt.A : cA; const char* nB = has_next ? nxt.B : cB;
        E.stage(cur, lds + SCLZ_OFF + (ui & 1) * 2048, wid, lane);
        if constexpr (Sched::GATHER) {
            if (has_next) S.arow4_dma(nxt, RA[0], RA[1], 128 + RA[0], 128 + RA[1], lds + GROW_OFF + wid * 256);
        }
        for (int t = 0; t < nt; t += 2) {
            const bool last = (t == nt - 2);
            const char* a1 = cA + (size_t)(t + 1) * kstep;
            const char* a2 = last ? nA : cA + (size_t)(t + 2) * kstep; const char* b2 = last ? nB : cB + (size_t)(t + 2) * kstep;
            const char* a3 = a2 + kstep; const char* b3 = b2 + kstep;
            unsigned s00 = c00, s01 = c01, s10 = c10, s11 = c11;
            if constexpr (Sched::GATHER) {
                if (last && has_next) {
                    const volatile LAS unsigned* gr = (const volatile LAS unsigned*)(lds + GROW_OFF + wid * 256) + lane;
                    n00 = gr[0]; n01 = gr[512]; n10 = gr[1024]; n11 = gr[1536];
                    S.arow4_finish(nxt, RA[0], RA[1], 128 + RA[0], 128 + RA[1], CA[0] * 2u, CA[1] * 2u, n00, n01, n10, n11);
                }
                if (last) { s00 = n00; s01 = n01; s10 = n10; s11 = n11; }
            }
            PG8_LDB(B0, 0, 0); PG8_LDB(B1, 0, 1); PG8_SCHED; PG8_LDA(At, 0, 0); PG8_STAGE_A(PG8_SA(1, 1), a1, c10, c11);
            PG8_WAIT_V(8); PG8_WAIT_L(0); PG8_BAR; PG8_MMA(0, 0, At, B0); PG8_MMA(0, 1, At, B1); PG8_BAR; PG8_SCHED;
            PG8_LDA(At, 0, 1); PG8_STAGE_B(PG8_SB(0, 0), b2); PG8_STAGE_B(PG8_SB(0, 1), b2 + hstep); PG8_STAGE_A(PG8_SA(0, 0), a2, s00, s01);
            PG8_WAIT_V(8); PG8_WAIT_L(0); PG8_BAR; PG8_MMA(1, 0, At, B0); PG8_MMA(1, 1, At, B1); PG8_BAR; PG8_SCHED;
            PG8_LDB(B0, 1, 0); PG8_LDB(B1, 1, 1); PG8_SCHED; PG8_LDA(At, 1, 0); PG8_STAGE_A(PG8_SA(0, 1), a2, s10, s11);
            PG8_WAIT_V(8); PG8_WAIT_L(0); PG8_BAR; PG8_MMA(0, 0, At, B0); PG8_MMA(0, 1, At, B1); PG8_BAR; PG8_SCHED;
            PG8_LDA(At, 1, 1); PG8_STAGE_B(PG8_SB(1, 0), b3); PG8_STAGE_B(PG8_SB(1, 1), b3 + hstep); PG8_STAGE_A(PG8_SA(1, 0), a3, s00, s01);
            PG8_WAIT_V(8); PG8_WAIT_L(0); PG8_BAR; PG8_MMA(1, 0, At, B0); PG8_MMA(1, 1, At, B1); PG8_BAR; PG8_SCHED;
        }
        if constexpr (ALIGN_EPI) { if (wr == 0) PG8_BAR; }
        E(acc, cur, wr, wc, fr, fq, lds + SCLZ_OFF + (ui & 1) * 2048);
        if (!has_next) break;
#pragma unroll
        for (int a = 0; a < 2; ++a)
#pragma unroll
            for (int b = 0; b < 2; ++b)
#pragma unroll
                for (int m = 0; m < 4; ++m)
#pragma unroll
                    for (int n = 0; n < 2; ++n) acc[a][b][m][n] = (AccT){0, 0, 0, 0};
        cur = nxt; cA = nA; cB = nB; ++ui;
        c00 = n00; c01 = n01; c10 = n10; c11 = n11;
        if constexpr (ALIGN_EPI) { if (wr == 1) PG8_BAR; }
    }
    PG8_WAIT_V(0);
    if constexpr (!ALIGN_EPI) { if (wr == 0) PG8_BAR; }
    PG8_BAR;
#undef PG8_SA
#undef PG8_SB
#undef PG8_STAGE_A
#undef PG8_STAGE_B
#undef PG8_LDA
#undef PG8_LDB
#undef PG8_MMA
#undef PG8_WAIT_V
#undef PG8_WAIT_L
#undef PG8_BAR
#undef PG8_SCHED
}
}

struct SchedInproj {
    static constexpr bool GATHER = false;
    const char* H; const char* W; int G, c;
    template <bool UNI = true> __device__ __forceinline__ bool next(int i, pg8::Unit& u) const {
        const int L = i * G + c; if (L >= 2304 + 128) return false;
        int pm, pn;
        if (L < 2304) pg8::rect_order(L, 64, 36, pm, pn);
        else { const int idx = L - 2304, q = idx >> 3; pm = 64 + (idx & 7); pn = q < 4 ? q : q + 8; }
        u.pm = pm; u.pn = pn; u.e = 0; u.aux = 0; u.idx = i;
        u.A = H + (size_t)pm * 256 * D; u.B = W + (size_t)pn * 256 * D; return true;
    }
    __device__ __forceinline__ unsigned arow(const pg8::Unit&, int) const { return 0u; }
};
struct SchedSq {
    static constexpr bool GATHER = false;
    const char* A; const char* W; int G, c;
    __device__ __forceinline__ bool next(int i, pg8::Unit& u) const {
        const int L = i * G + c; if (L >= 256) return false;
        int pm, pn; pg8::rect_order(L, 64, 4, pm, pn);
        u.pm = pm; u.pn = pn; u.e = 0; u.aux = 0; u.idx = i;
        u.A = A + (size_t)pm * 256 * D * 2; u.B = W + (size_t)pn * 256 * D * 2; return true;
    }
    __device__ __forceinline__ unsigned arow(const pg8::Unit&, int) const { return 0u; }
};
template <int NT, bool GATH> struct SchedMoe {
    static constexpr bool GATHER = GATH;
    const char* A; const char* W; const int* list; volatile LAS int* tab; int G, c, pb;
    template <bool UNI = true> __device__ __forceinline__ bool next(int i, pg8::Unit& u) const {
        const int L = i * G + c; const int total = tab[32] * NT; if (L >= total) return false;
        int e = 0;
        if constexpr (UNI) {
            const int lj = (int)(threadIdx.x & 31);
            const unsigned long long bal = __ballot(tab[lj] * NT <= L);
            e = __builtin_popcount((unsigned)bal) - 1;
        } else {
#pragma unroll 1
            for (int j = 1; j < 32; ++j) if (L >= tab[j] * NT) e = j;
        }
        const int tp = tab[e], tiles = tab[e + 1] - tp, local = L - tp * NT;
        const int mt = local % tiles, nt = local / tiles;
        u.pm = mt; u.pn = nt; u.e = e; u.aux = (tp + mt) * 256; u.idx = i;
        u.A = GATH ? A : A + (size_t)u.aux * pb;
        u.B = W + ((size_t)e * (NT * 256) + (size_t)nt * 256) * pb; return true;
    }
    __device__ __forceinline__ unsigned arow(const pg8::Unit& u, int R) const {
        const int pos = u.pm * 256 + R, n = tab[64 + u.e];
        const int tok = pos < n ? list[u.e * TL + pos] : 0;
        return (unsigned)tok * (unsigned)pb;
    }
    __device__ __forceinline__ void arow4_issue(const pg8::Unit& u, int R0, int R1, int R2, int R3, unsigned& o0, unsigned& o1, unsigned& o2, unsigned& o3) const {
        const int n = tab[64 + u.e], p0 = u.pm * 256 + R0, p1 = u.pm * 256 + R1, p2 = u.pm * 256 + R2, p3 = u.pm * 256 + R3;
        const int* lp = list + (size_t)u.e * TL;
        o0 = (unsigned)lp[p0 < n ? p0 : 0]; o1 = (unsigned)lp[p1 < n ? p1 : 0]; o2 = (unsigned)lp[p2 < n ? p2 : 0]; o3 = (unsigned)lp[p3 < n ? p3 : 0];
    }
    __device__ __forceinline__ void arow4_dma(const pg8::Unit& u, int R0, int R1, int R2, int R3, LAS unsigned char* dst) const {
        const int n = tab[64 + u.e], p0 = u.pm * 256 + R0, p1 = u.pm * 256 + R1, p2 = u.pm * 256 + R2, p3 = u.pm * 256 + R3;
        const int* lp = list + (size_t)u.e * TL;
        __builtin_amdgcn_global_load_lds((const unsigned*)(lp + (p0 < n ? p0 : 0)), (LAS unsigned*)dst, 4, 0, 0);
        __builtin_amdgcn_global_load_lds((const unsigned*)(lp + (p1 < n ? p1 : 0)), (LAS unsigned*)(dst + 2048), 4, 0, 0);
        __builtin_amdgcn_global_load_lds((const unsigned*)(lp + (p2 < n ? p2 : 0)), (LAS unsigned*)(dst + 4096), 4, 0, 0);
        __builtin_amdgcn_global_load_lds((const unsigned*)(lp + (p3 < n ? p3 : 0)), (LAS unsigned*)(dst + 6144), 4, 0, 0);
    }
    __device__ __forceinline__ void arow4_finish(const pg8::Unit& u, int R0, int R1, int R2, int R3, unsigned c0, unsigned c1, unsigned& o0, unsigned& o1, unsigned& o2, unsigned& o3) const {
        const int n = tab[64 + u.e], p0 = u.pm * 256 + R0, p1 = u.pm * 256 + R1, p2 = u.pm * 256 + R2, p3 = u.pm * 256 + R3;
        o0 = (p0 < n ? o0 : 0u) * (unsigned)pb + c0; o1 = (p1 < n ? o1 : 0u) * (unsigned)pb + c1; o2 = (p2 < n ? o2 : 0u) * (unsigned)pb + c0; o3 = (p3 < n ? o3 : 0u) * (unsigned)pb + c1;
    }
};

constexpr int UCAP = 12, UC_ROWS = 131072, UC_REC = UC_ROWS + UCAP * 1024;
template <class Base, bool ROWS = true> struct SchedCached {
    static constexpr bool GATHER = Base::GATHER;
    Base base; LAS unsigned char* lds;
    __device__ __forceinline__ void init(int tid) {
        volatile LAS unsigned* rec = (volatile LAS unsigned*)(lds + UC_REC);
        if (tid < UCAP) { pg8::Unit u; const bool ok = base.template next<false>(tid, u);
            const unsigned long long a = (unsigned long long)u.A, b = (unsigned long long)u.B;
            rec[tid * 8 + 0] = ok ? (unsigned)a : 0u; rec[tid * 8 + 1] = ok ? (unsigned)(a >> 32) : 0u; rec[tid * 8 + 2] = ok ? (unsigned)b : 0u; rec[tid * 8 + 3] = ok ? (unsigned)(b >> 32) : 0u;
            rec[tid * 8 + 4] = ok ? ((unsigned)u.pm | ((unsigned)u.pn << 16)) : 0xffffffffu; rec[tid * 8 + 5] = (unsigned)u.e; rec[tid * 8 + 6] = (unsigned)u.aux; rec[tid * 8 + 7] = ok ? 1u : 0u; }
        __syncthreads();
        if constexpr (Base::GATHER && ROWS) {
            volatile LAS int* rows = (volatile LAS int*)(lds + UC_ROWS);
            for (int x = tid; x < UCAP * 256; x += NWAVES * 64) { const int i = x >> 8, r = x & 255;
                if (rec[i * 8 + 7]) { pg8::Unit u; u.pm = (int)(rec[i * 8 + 4] & 0xffffu); u.e = (int)rec[i * 8 + 5]; rows[x] = (int)base.arow(u, r); } }
            __syncthreads();
        }
    }
    __device__ __forceinline__ bool next(int i, pg8::Unit& u) const {
        if (i >= UCAP) { const bool ok = base.next(i, u); u.idx = i; return ok; }
        volatile LAS unsigned* rec = (volatile LAS unsigned*)(lds + UC_REC) + i * 8;
        if (!rec[7]) return false;
        u.A = (const char*)((unsigned long long)rec[0] | ((unsigned long long)rec[1] << 32)); u.B = (const char*)((unsigned long long)rec[2] | ((unsigned long long)rec[3] << 32));
        const unsigned pp = rec[4]; u.pm = (int)(pp & 0xffffu); u.pn = (int)(pp >> 16); u.e = (int)rec[5]; u.aux = (int)rec[6]; u.idx = i; return true;
    }
    __device__ __forceinline__ unsigned arow(const pg8::Unit& u, int R) const {
        if constexpr (Base::GATHER && ROWS) { if (u.idx < UCAP) return (unsigned)((volatile LAS int*)(lds + UC_ROWS))[u.idx * 256 + R]; }
        return base.arow(u, R);
    }
    __device__ __forceinline__ void arow4_issue(const pg8::Unit&, int, int, int, int, unsigned&, unsigned&, unsigned&, unsigned&) const {}
    __device__ __forceinline__ void arow4_dma(const pg8::Unit&, int, int, int, int, LAS unsigned char*) const {}
    __device__ __forceinline__ void arow4_finish(const pg8::Unit& u, int R0, int R1, int R2, int R3, unsigned c0, unsigned c1, unsigned& o0, unsigned& o1, unsigned& o2, unsigned& o3) const {
        o0 = arow(u, R0) + c0; o1 = arow(u, R1) + c1; o2 = arow(u, R2) + c0; o3 = arow(u, R3) + c1;
    }
};

struct EpiInproj {
    static constexpr bool PERM = true, HAS_MID = false;
    bf16* P; const float* hs; const float* ws;
    template <bool ACT> __device__ __forceinline__ void body(const i32x4 (&acc)[2][2][4][2], bf16* rowbase, const float (&rsv)[2][4], const f32x4 (&wv)[2][2], float c1, float c3, bool sig) const {
#pragma unroll
        for (int ai = 0; ai < 2; ++ai)
#pragma unroll
            for (int m = 0; m < 4; ++m) { const float rs = rsv[ai][m]; bf16* rowp = rowbase + (size_t)(ai * 128 + m * 16) * D;
#pragma unroll
                for (int bj = 0; bj < 2; ++bj) { float o[8];
#pragma unroll
                    for (int q = 0; q < 8; ++q) { const float x = (float)acc[ai][bj][m][q >> 2][q & 3] * (rs * wv[bj][q >> 2][q & 3]);
                        if (!ACT) o[q] = x; else { const float z = x * (c1 + c3 * x * x); const float sg = fast_sigmoid(z); o[q] = sig ? sg : x * sg; } }
                    u32x4 w; w.x = pkbf(o[0], o[1]); w.y = pkbf(o[2], o[3]); w.z = pkbf(o[4], o[5]); w.w = pkbf(o[6], o[7]);
                    __builtin_nontemporal_store(w, (u32x4*)(rowp + bj * 128)); } }
    }
    __device__ __forceinline__ void stage(const pg8::Unit& u, LAS unsigned char* z, int wid, int lane) const {
        if (wid == 0) __builtin_amdgcn_global_load_lds((const unsigned*)(hs + u.pm * 256 + 4 * lane), (LAS unsigned*)z, 16, 0, 0);
        if (wid == 1) __builtin_amdgcn_global_load_lds((const unsigned*)(ws + u.pn * 256 + 4 * lane), (LAS unsigned*)(z + 1024), 16, 0, 0);
    }
    __device__ __forceinline__ void operator()(const i32x4 (&acc)[2][2][4][2], const pg8::Unit& u, int wr, int wc, int fr, int fq, const LAS unsigned char* z) const {
        const int pn = __builtin_amdgcn_readfirstlane(u.pn), pm = __builtin_amdgcn_readfirstlane(u.pm);
        const int grp = pn >> 2, colt = (pn & 3) * 256;
        const int row0 = pm * 256 + wr * 64 + fr, col0 = colt + wc * 32 + 8 * fq;
        const int mode = (grp == 1) ? 1 : (grp == 2 || grp == 6) ? 2 : (grp >= 7) ? 3 : 0;
        f32x4 wv[2][2]; float rsv[2][4];
        const LAS float* zr = (const LAS float*)z + wr * 64 + fr; const LAS float* zc = (const LAS float*)(z + 1024) + wc * 32 + 8 * fq;
#pragma unroll
        for (int bj = 0; bj < 2; ++bj)
#pragma unroll
            for (int n = 0; n < 2; ++n) wv[bj][n] = *(const LAS f32x4*)(zc + bj * 128 + 4 * n);
#pragma unroll
        for (int ai = 0; ai < 2; ++ai)
#pragma unroll
            for (int m = 0; m < 4; ++m) rsv[ai][m] = zr[ai * 128 + m * 16];
        bf16* rowbase = P + (size_t)grp * PG_STRIDE + (size_t)row0 * D + col0;
        if (mode == 0) body<false>(acc, rowbase, rsv, wv, 1.f, 0.f, false);
        else body<true>(acc, rowbase, rsv, wv, (mode == 1) ? 1.5957691216f : 1.f, (mode == 1) ? 0.0713548163f : 0.f, mode == 3);
    }
};
template <int MODE> struct EpiMerge {
    static constexpr bool PERM = true;
    bf16* O; const bf16* gate; const bf16* prev;
    __device__ __forceinline__ void stage(const pg8::Unit&, LAS unsigned char*, int, int) const {}
    __device__ __forceinline__ void operator()(const f32x4 (&acc)[2][2][4][2], const pg8::Unit& u, int wr, int wc, int fr, int fq, const LAS unsigned char*) const {
        const int row0 = u.pm * 256 + wr * 64 + fr, col0 = u.pn * 256 + wc * 32 + 8 * fq;
        const size_t off0 = (size_t)row0 * D + col0;
        u32x4 g[2][4][2], p[MODE == 1 ? 2 : 1][4][2], w[2][4][2];
#define EM_LOAD(ai) do { _Pragma("unroll") for (int m = 0; m < 4; ++m) _Pragma("unroll") for (int bj = 0; bj < 2; ++bj) { const size_t off = off0 + (size_t)((ai) * 128 + m * 16) * D + bj * 128; \
            g[ai][m][bj] = *(const u32x4*)(gate + off); if (MODE == 1) p[MODE == 1 ? (ai) : 0][m][bj] = *(const u32x4*)(prev + off); } } while (0)
#define EM_CALC(ai) do { _Pragma("unroll") for (int m = 0; m < 4; ++m) _Pragma("unroll") for (int bj = 0; bj < 2; ++bj) { const u32x4 gg = g[ai][m][bj]; float o[8]; const f32x4 v0 = acc[ai][bj][m][0], v1 = acc[ai][bj][m][1]; \
            o[0] = v0[0] * bflo(gg.x); o[1] = v0[1] * bfhi(gg.x); o[2] = v0[2] * bflo(gg.y); o[3] = v0[3] * bfhi(gg.y); o[4] = v1[0] * bflo(gg.z); o[5] = v1[1] * bfhi(gg.z); o[6] = v1[2] * bflo(gg.w); o[7] = v1[3] * bfhi(gg.w); \
            if (MODE == 1) { const u32x4 pp = p[MODE == 1 ? (ai) : 0][m][bj]; o[0] += bflo(pp.x); o[1] += bfhi(pp.x); o[2] += bflo(pp.y); o[3] += bfhi(pp.y); o[4] += bflo(pp.z); o[5] += bfhi(pp.z); o[6] += bflo(pp.w); o[7] += bfhi(pp.w); } \
            w[ai][m][bj] = (u32x4){pkbf(o[0], o[1]), pkbf(o[2], o[3]), pkbf(o[4], o[5]), pkbf(o[6], o[7])}; } } while (0)
#define EM_STORE(ai) do { _Pragma("unroll") for (int m = 0; m < 4; ++m) _Pragma("unroll") for (int bj = 0; bj < 2; ++bj) *(u32x4*)(O + off0 + (size_t)((ai) * 128 + m * 16) * D + bj * 128) = w[ai][m][bj]; } while (0)
        EM_LOAD(0); __builtin_amdgcn_sched_barrier(0); EM_CALC(0); __builtin_amdgcn_sched_barrier(0);
        EM_LOAD(1); __builtin_amdgcn_sched_barrier(0); EM_STORE(0); __builtin_amdgcn_sched_barrier(0);
        EM_CALC(1); EM_STORE(1);
#undef EM_LOAD
#undef EM_CALC
#undef EM_STORE
    }
};
struct EpiX1 {
    static constexpr bool PERM = false;
    float* X1; const float* x; const float* mod;
    __device__ __forceinline__ void stage(const pg8::Unit&, LAS unsigned char*, int, int) const {}
    __device__ __forceinline__ void operator()(const f32x4 (&acc)[2][2][4][2], const pg8::Unit& u, int wr, int wc, int fr, int fq, const LAS unsigned char*) const {
        const int row0 = u.pm * 256 + wr * 64 + fr, col0 = u.pn * 256 + wc * 32 + 4 * fq;
        const float* mg = mod + (size_t)(u.pm >> 3) * NMOD + 2 * D;
        f32x4 gv[2][2];
#pragma unroll
        for (int bj = 0; bj < 2; ++bj)
#pragma unroll
            for (int n = 0; n < 2; ++n) gv[bj][n] = *(const f32x4*)(mg + col0 + bj * 128 + n * 16);
        const size_t off0 = (size_t)row0 * D + col0;
        f32x4 xv[2][4][2][2];
#define EX_LOAD(ai) do { _Pragma("unroll") for (int m = 0; m < 4; ++m) _Pragma("unroll") for (int bj = 0; bj < 2; ++bj) _Pragma("unroll") for (int n = 0; n < 2; ++n) \
            xv[ai][m][bj][n] = *(const f32x4*)(x + off0 + (size_t)((ai) * 128 + m * 16) * D + bj * 128 + n * 16); } while (0)
#define EX_CALC(ai) do { _Pragma("unroll") for (int m = 0; m < 4; ++m) _Pragma("unroll") for (int bj = 0; bj < 2; ++bj) _Pragma("unroll") for (int n = 0; n < 2; ++n) \
            xv[ai][m][bj][n] = xv[ai][m][bj][n] + gv[bj][n] * acc[ai][bj][m][n]; } while (0)
#define EX_STORE(ai) do { _Pragma("unroll") for (int m = 0; m < 4; ++m) _Pragma("unroll") for (int bj = 0; bj < 2; ++bj) _Pragma("unroll") for (int n = 0; n < 2; ++n) \
            *(f32x4*)(X1 + off0 + (size_t)((ai) * 128 + m * 16) * D + bj * 128 + n * 16) = xv[ai][m][bj][n]; } while (0)
        EX_LOAD(0); __builtin_amdgcn_sched_barrier(0); EX_CALC(0); __builtin_amdgcn_sched_barrier(0);
        EX_LOAD(1); __builtin_amdgcn_sched_barrier(0); EX_STORE(0); __builtin_amdgcn_sched_barrier(0);
        EX_CALC(1); EX_STORE(1);
#undef EX_LOAD
#undef EX_CALC
#undef EX_STORE
    }
};
struct EpiAct {
    static constexpr bool PERM = true, HAS_MID = false;
    bf16* ACT; const float* b1; const float* scl; const float* sw1;
    __device__ __forceinline__ void stage(const pg8::Unit& u, LAS unsigned char* z, int wid, int lane) const {
        if (wid == 0) __builtin_amdgcn_global_load_lds((const unsigned*)(scl + (size_t)u.e * TL + u.pm * 256 + 4 * lane), (LAS unsigned*)z, 16, 0, 0);
        if (wid == 1) __builtin_amdgcn_global_load_lds((const unsigned*)(b1 + (size_t)u.e * 2048 + u.pn * 256 + 4 * lane), (LAS unsigned*)(z + 1024), 16, 0, 0);
    }
    __device__ __forceinline__ void operator()(const i32x4 (&acc)[2][2][4][2], const pg8::Unit& u, int wr, int wc, int fr, int fq, const LAS unsigned char* z) const {
        const int row0 = u.aux + wr * 64 + fr;
        const int vc0 = u.pn * 256 + wc * 32 + 8 * fq;
        const float sw = sw1[u.e];
        float rs[2][4]; f32x4 ba[2], bbv[2];
        const LAS float* zr = (const LAS float*)z + wr * 64 + fr; const LAS float* zc = (const LAS float*)(z + 1024) + wc * 32 + 8 * fq;
#pragma unroll
        for (int ai = 0; ai < 2; ++ai)
#pragma unroll
            for (int m = 0; m < 4; ++m) rs[ai][m] = zr[ai * 128 + m * 16];
#pragma unroll
        for (int bj = 0; bj < 2; ++bj) { ba[bj] = *(const LAS f32x4*)(zc + bj * 128); bbv[bj] = *(const LAS f32x4*)(zc + bj * 128 + 4); }
#pragma unroll
        for (int ai = 0; ai < 2; ++ai)
#pragma unroll
            for (int m = 0; m < 4; ++m) rs[ai][m] *= sw;
#pragma unroll
        for (int bj = 0; bj < 2; ++bj) {
            const int vc = vc0 + bj * 128, j0 = vc >> 1;
            const float bg[4] = {ba[bj][0], ba[bj][2], bbv[bj][0], bbv[bj][2]}, bu[4] = {ba[bj][1], ba[bj][3], bbv[bj][1], bbv[bj][3]};
#pragma unroll
            for (int ai = 0; ai < 2; ++ai)
#pragma unroll
                for (int m = 0; m < 4; ++m) { float o[4];
#pragma unroll
                    for (int q = 0; q < 4; ++q) { float hg = (float)acc[ai][bj][m][0][q] * rs[ai][m] + bg[q], hu = (float)acc[ai][bj][m][1][q] * rs[ai][m] + bu[q];
                        hg = fminf(hg, 7.0f); hu = fminf(fmaxf(hu, -7.0f), 7.0f);
                        o[q] = hg * fast_sigmoid(1.702f * hg) * (hu + 1.0f); }
                    u32x2 w; w.x = pkbf(o[0], o[1]); w.y = pkbf(o[2], o[3]);
                    *(u32x2*)(ACT + (size_t)(row0 + ai * 128 + m * 16) * D + j0) = w; }
        }
    }
};
struct EpiY {
    static constexpr bool PERM = true;
    bf16* Y; const float* b2;
    __device__ __forceinline__ void stage(const pg8::Unit& u, LAS unsigned char* z, int wid, int lane) const {
        if (wid == 1) __builtin_amdgcn_global_load_lds((const unsigned*)(b2 + (size_t)u.e * D + u.pn * 256 + 4 * lane), (LAS unsigned*)(z + 1024), 16, 0, 0);
    }
    __device__ __forceinline__ void operator()(const f32x4 (&acc)[2][2][4][2], const pg8::Unit& u, int wr, int wc, int fr, int fq, const LAS unsigned char* z) const {
        const int row0 = u.aux + wr * 64 + fr, col0 = u.pn * 256 + wc * 32 + 8 * fq;
        const LAS float* zc = (const LAS float*)(z + 1024) + wc * 32 + 8 * fq;
        f32x4 bv[2][2];
#pragma unroll
        for (int bj = 0; bj < 2; ++bj)
#pragma unroll
            for (int n = 0; n < 2; ++n) bv[bj][n] = *(const LAS f32x4*)(zc + bj * 128 + 4 * n);
#pragma unroll
        for (int ai = 0; ai < 2; ++ai)
#pragma unroll
            for (int m = 0; m < 4; ++m) { bf16* rowp = Y + (size_t)(row0 + ai * 128 + m * 16) * D + col0;
#pragma unroll
                for (int bj = 0; bj < 2; ++bj) { const f32x4 v0 = acc[ai][bj][m][0] + bv[bj][0], v1 = acc[ai][bj][m][1] + bv[bj][1];
                    u32x4 w; w.x = pkbf(v0[0], v0[1]); w.y = pkbf(v0[2], v0[3]); w.z = pkbf(v1[0], v1[1]); w.w = pkbf(v1[2], v1[3]);
                    *(u32x4*)(rowp + bj * 128) = w; } }
    }
};

struct Args { const float* in[28]; float* out; unsigned char* ws; int ph_lo, ph_hi; };
struct Frame {
    LAS unsigned char* lds; int tid, lane, wave, G, vcu; unsigned char* ws; const float* const* in; float* out;
};
enum { I_X = 0, I_C, I_CTX, I_CCTX, I_ADAW, I_ADAB, I_N1G, I_N2G, I_WIN, I_CONVW, I_CONVB, I_WA, I_BA, I_WX, I_BX, I_LAM, I_LBL, I_HGG, I_WBA, I_WBB, I_WOUT,
       I_RW, I_RB, I_W1, I_B1, I_W2, I_B2, I_FG };

__device__ __forceinline__ void transpose_item(const float* W, int K, int N, bf16* WT, int row_off, LAS float* scr, int item, int lane, bool swz) {
    const int nblk = N / 32, kb = item / nblk, nb = item % nblk, k0 = 64 * kb, n0 = 32 * nb;
    float tv[32];
#pragma unroll
    for (int i = 0; i < 32; ++i) { const int kk = 2 * i + (lane >> 5); tv[i] = W[(size_t)(k0 + kk) * N + n0 + (lane & 31)]; }
#pragma unroll
    for (int i = 0; i < 32; ++i) { const int kk = 2 * i + (lane >> 5); scr[kk * 33 + (lane & 31)] = tv[i]; }
    LDS_WAIT(); asm volatile("" ::: "memory");
    const int c = lane & 7;
#pragma unroll
    for (int j = 0; j < 4; ++j) { const int n = (lane >> 3) + 8 * j; const LAS float* s = scr + (8 * c) * 33 + n;
        u32x4 o; o.x = pk2(s[0 * 33], s[1 * 33]); o.y = pk2(s[2 * 33], s[3 * 33]); o.z = pk2(s[4 * 33], s[5 * 33]); o.w = pk2(s[6 * 33], s[7 * 33]);
        const int x = n & 7, nv = swz ? ((n & ~7) + ((x & 1) * 4 + (x >> 1))) : n;
        *(u32x4*)(WT + (size_t)(row_off + n0 + nv) * K + k0 + 8 * c) = o; }
    LDS_WAIT(); asm volatile("" ::: "memory");
}
constexpr int MOE_ITEMS = 32 * 32 * 64 + 32 * 32 * 32;
struct MoeItem { const float* W; bf16* WT; int N, k0, n0; bool swz; float inv; };
template <bool LOAD_INV = true> __device__ __forceinline__ MoeItem moe_item(const Frame& F, int item) {
    MoeItem m;
    if (item < 65536) { const int e = item >> 11, sub = item & 2047, kb = sub >> 6, nb = sub & 63;
        m.W = F.in[I_W1] + (size_t)e * D * 2048; m.WT = (bf16*)(F.ws + WS_W1 + (size_t)e * 2048 * D); m.N = 2048; m.k0 = kb * 32; m.n0 = nb * 32; m.swz = true; m.inv = LOAD_INV ? ((const float*)(F.ws + WS_SW1))[32 + e] : 1.0f; }
    else { const int r = item - 65536, e = r >> 10, sub = r & 1023, kb = sub >> 5, nb = sub & 31;
        m.W = F.in[I_W2] + (size_t)e * D * D; m.WT = (bf16*)(F.ws + WS_W2) + (size_t)e * D * D; m.N = D; m.k0 = kb * 32; m.n0 = nb * 32; m.swz = false; m.inv = 1.0f; }
    return m;
}
__device__ __forceinline__ void moe_conv_issue(const MoeItem& m, int lane, float (&tv)[16]) {
#pragma unroll
    for (int i = 0; i < 16; ++i) tv[i] = m.W[(size_t)(m.k0 + 2 * i + (lane >> 5)) * m.N + m.n0 + (lane & 31)];
}
__device__ __forceinline__ void moe_conv_finish(const MoeItem& m, int lane, const float (&tv)[16], LAS float* scr) {
#pragma unroll
    for (int i = 0; i < 16; ++i) scr[(2 * i + (lane >> 5)) * 33 + (lane & 31)] = tv[i];
    asm volatile("" ::: "memory");
    const int n = lane >> 1, hk = (lane & 1) * 16;
    const int x = n & 7, nv = m.swz ? ((n & ~7) + ((x & 1) * 4 + (x >> 1))) : n;
    if (m.swz) {
        unsigned o[4];
#pragma unroll
        for (int j = 0; j < 4; ++j) { unsigned wv = 0u;
#pragma unroll
            for (int b = 0; b < 4; ++b) { int q = (int)rintf(scr[(hk + 4 * j + b) * 33 + n] * m.inv); q = q > 127 ? 127 : (q < -127 ? -127 : q); wv |= (unsigned)(q & 255) << (8 * b); }
            o[j] = wv; }
        unsigned char* dst = (unsigned char*)m.WT + (size_t)(m.n0 + nv) * D + m.k0 + hk;
        *(u32x4*)dst = (u32x4){o[0], o[1], o[2], o[3]};
    } else {
        unsigned o[8];
#pragma unroll
        for (int j = 0; j < 8; ++j) o[j] = pkbf(scr[(hk + 2 * j) * 33 + n], scr[(hk + 2 * j + 1) * 33 + n]);
        bf16* dst = m.WT + (size_t)(m.n0 + nv) * D + m.k0 + hk;
        *(u32x4*)dst = (u32x4){o[0], o[1], o[2], o[3]}; *(u32x4*)(dst + 8) = (u32x4){o[4], o[5], o[6], o[7]};
    }
    asm volatile("" ::: "memory");
}
__device__ __forceinline__ void moe_dma_issue(const MoeItem& m, int lane, LAS unsigned char* scr) {
#pragma unroll
    for (int j = 0; j < 4; ++j) { const int q = j * 64 + lane, r = q >> 3, c = (q & 7) ^ (r & 7);
        __builtin_amdgcn_global_load_lds((const unsigned*)(m.W + (size_t)(m.k0 + r) * m.N + m.n0 + 4 * c), (LAS unsigned*)(scr + j * 1024), 16, 0, 0); }
}
__device__ __forceinline__ void moe_dma_finish(const MoeItem& m, int lane, const LAS unsigned char* scr) {
    const int n = lane >> 1, hk = (lane & 1) * 16;
    const int x = n & 7, nv = m.swz ? ((n & ~7) + ((x & 1) * 4 + (x >> 1))) : n;
    float v[16];
#pragma unroll
    for (int i = 0; i < 16; ++i) { const int r = hk + i; v[i] = *(const LAS float*)(scr + r * 128 + (((n >> 2) ^ (r & 7)) * 16) + (n & 3) * 4); }
    if (m.swz) {
        unsigned o[4];
#pragma unroll
        for (int j = 0; j < 4; ++j) { unsigned wv = 0u;
#pragma unroll
            for (int b = 0; b < 4; ++b) { int q = (int)rintf(v[4 * j + b] * m.inv); q = q > 127 ? 127 : (q < -127 ? -127 : q); wv |= (unsigned)(q & 255) << (8 * b); }
            o[j] = wv; }
        unsigned char* dst = (unsigned char*)m.WT + (size_t)(m.n0 + nv) * D + m.k0 + hk;
        *(u32x4*)dst = (u32x4){o[0], o[1], o[2], o[3]};
    } else {
        unsigned o[8];
#pragma unroll
        for (int j = 0; j < 8; ++j) o[j] = pkbf(v[2 * j], v[2 * j + 1]);
        bf16* dst = m.WT + (size_t)(m.n0 + nv) * D + m.k0 + hk;
        *(u32x4*)dst = (u32x4){o[0], o[1], o[2], o[3]}; *(u32x4*)(dst + 8) = (u32x4){o[4], o[5], o[6], o[7]};
    }
}
__device__ __forceinline__ void p0_prologue(const Frame& F) {
    {
        LAS float* sc = (LAS float*)F.lds;
        LAS float* red = (LAS float*)(F.lds + 40960);
        bool loaded = false;
        for (int item = blockIdx.x; item < NMOD / 32; item += F.G) {
            if (!loaded) {
                for (int i = F.tid; i < 9 * D; i += 512) { const int v = i >> 10, k = i & 1023; const float cvv = v < 8 ? F.in[I_C][v * D + k] : F.in[I_CCTX][k];
                    sc[i] = cvv / (1.0f + __expf(-cvv)); }
                loaded = true; __syncthreads();
            }
            const int col = F.tid & 31, kg = F.tid >> 5, n0 = item * 32;
            float a[9];
#pragma unroll
            for (int v = 0; v < 9; ++v) a[v] = 0.f;
            const float* wp = F.in[I_ADAW] + n0 + col;
            float wv[64];
#pragma unroll
            for (int kk = 0; kk < 64; ++kk) wv[kk] = wp[(size_t)(kg + 16 * kk) * NMOD];
#pragma unroll
            for (int kk = 0; kk < 64; ++kk) { const int k = kg + 16 * kk; const float w = wv[kk];
#pragma unroll
                for (int v = 0; v < 9; ++v) a[v] += sc[v * D + k] * w; }
#pragma unroll
            for (int v = 0; v < 9; ++v) red[(kg * 9 + v) * 32 + col] = a[v];
            __syncthreads();
            if (F.tid < 288) { const int v = F.tid >> 5, cc = F.tid & 31; float s = 0.f;
#pragma unroll
                for (int g = 0; g < 16; ++g) s += red[(g * 9 + v) * 32 + cc];
                ((float*)(F.ws + WS_MOD))[(size_t)v * NMOD + n0 + cc] = s + F.in[I_ADAB][n0 + cc]; }
            __syncthreads();
        }
        __syncthreads();
    }
    if (blockIdx.x == F.G - 1) { for (int i = F.tid; i < 2 * D; i += 512) { const float nl = -F.in[I_LAM][i]; ((float*)(F.ws + WS_SPL))[i] = 1.44269504089f * 8.0f * (fmaxf(nl, 0.f) + log1pf(expf(-fabsf(nl)))); } }
    if (blockIdx.x < 32) {
        LAS float* RD = (LAS float*)(F.lds + 65536);
        const float* W = F.in[I_W1] + (size_t)blockIdx.x * D * 2048;
        float mx = 0.f;
#pragma unroll 8
        for (int i = 0; i < 64; ++i) { const f32x4 v = *(const f32x4*)(W + (size_t)i * 2048 + 4 * F.tid); mx = fmaxf(mx, fmaxf(fmaxf(fabsf(v[0]), fabsf(v[1])), fmaxf(fabsf(v[2]), fabsf(v[3])))); }
#pragma unroll
        for (int o = 1; o < 64; o <<= 1) mx = fmaxf(mx, __shfl_xor(mx, o));
        if (F.lane == 0) RD[F.wave] = mx;
        __syncthreads();
        if (F.tid == 0) { float m8 = 0.f; for (int w8 = 0; w8 < 8; ++w8) m8 = fmaxf(m8, RD[w8]); const float sc = m8 > 0.f ? 1.3f * m8 * (1.0f / 127.0f) : 1.0f; ((float*)(F.ws + WS_SW1))[blockIdx.x] = sc; ((float*)(F.ws + WS_SW1))[32 + blockIdx.x] = 1.0f / sc; }
        __syncthreads();
    }
    {
        LAS float* CM = (LAS float*)(F.lds + 65536);
        LAS unsigned char* T8 = F.lds + 66560 + F.wave * 4224;
        const float* W = F.in[I_WIN]; unsigned char* WT = F.ws + WS_WIN; float* WSC = (float*)(F.ws + WS_WINS);
        for (int slab = blockIdx.x; slab < 288; slab += F.G) {
            const int n0 = slab * 32, col = F.lane & 31, hi = F.lane >> 5, k0 = 128 * F.wave;
            float tv[64]; float mx = 0.f;
#pragma unroll
            for (int i = 0; i < 64; ++i) { tv[i] = W[(size_t)(k0 + 2 * i + hi) * (9 * D) + n0 + col]; }
#pragma unroll
            for (int i = 0; i < 64; ++i) mx = fmaxf(mx, fabsf(tv[i]));
            mx = fmaxf(mx, __shfl_xor(mx, 32));
            if (hi == 0) CM[F.wave * 32 + col] = mx;
            __syncthreads();
            float cmx = 0.f;
#pragma unroll
            for (int w8 = 0; w8 < 8; ++w8) cmx = fmaxf(cmx, CM[w8 * 32 + col]);
            const float sc = cmx > 0.f ? cmx * (1.0f / 127.0f) : 1.0f, inv = 1.0f / sc;
            if (F.wave == 0 && hi == 0) WSC[n0 + col] = sc;
#pragma unroll
            for (int i = 0; i < 64; ++i) T8[col * 132 + 2 * i + hi] = (unsigned char)((int)rintf(tv[i] * inv) & 255);
            LDS_WAIT(); asm volatile("" ::: "memory");
#pragma unroll
            for (int j = 0; j < 4; ++j) { const int ch = F.lane + 64 * j, n = ch >> 3, c16 = ch & 7;
                const LAS unsigned* sp = (const LAS unsigned*)(T8 + n * 132 + c16 * 16);
                *(u32x4*)(WT + (size_t)(n0 + n) * D + k0 + c16 * 16) = (u32x4){sp[0], sp[1], sp[2], sp[3]}; }
            __syncthreads();
        }
    }
    LAS float* scr = (LAS float*)(F.lds + F.wave * 16384);
    const int gw = F.vcu * NWAVES + F.wave, NGW = F.G * NWAVES;
    constexpr int I_SQ = 16 * 32, I_LRU = 32 * 8;
    constexpr int NITEMS = 3 * I_SQ + I_LRU;
    for (int it = gw; it < NITEMS; it += NGW) {
        int r = it;
        if (r < I_SQ) { transpose_item(F.in[I_WBA], D, D, (bf16*)(F.ws + WS_WBA), 0, scr, r, F.lane, false); continue; } r -= I_SQ;
        if (r < I_SQ) { transpose_item(F.in[I_WBB], D, D, (bf16*)(F.ws + WS_WBB), 0, scr, r, F.lane, false); continue; } r -= I_SQ;
        if (r < I_SQ) { transpose_item(F.in[I_WOUT], D, D, (bf16*)(F.ws + WS_WOUT), 0, scr, r, F.lane, false); continue; } r -= I_SQ;
        { const int mat = r >> 3, sub = r & 7, z = mat >> 4, dg = mat & 15, d = dg >> 3, g = dg & 7;
            transpose_item(F.in[z ? I_WX : I_WA] + (size_t)dg * 16384, 128, 128, (bf16*)(F.ws + WS_LRUW) + (size_t)((d * 2 + z) * 8 + g) * 16384, 0, scr, sub, F.lane, false); }
    }
}

__device__ __forceinline__ void p1_norm(const Frame& F) {
    const int gw = F.vcu * NWAVES + F.wave, NGW = F.G * NWAVES;
    const float* g1 = F.in[I_N1G]; const float* mod = (const float*)(F.ws + WS_MOD);
    unsigned char* H = F.ws + WS_H; float* HS = (float*)(F.ws + WS_HS);
    for (int r = gw; r < TT; r += NGW) {
        const float* src = r < TL ? F.in[I_X] + (size_t)r * D : F.in[I_CTX] + (size_t)(r - TL) * D;
        const float* mv = mod + (size_t)(r < TL ? (r >> 11) : 8) * NMOD;
        f32x4 v[4]; float ss = 0.f;
#pragma unroll
        for (int j = 0; j < 4; ++j) { v[j] = *(const f32x4*)(src + 4 * F.lane + 256 * j); ss += (v[j][0] * v[j][0] + v[j][1] * v[j][1]) + (v[j][2] * v[j][2] + v[j][3] * v[j][3]); }
        const float rstd = 1.0f / sqrtf(wave_sum(ss) * (1.0f / D) + EPS);
        float amax = 0.f;
#pragma unroll
        for (int j = 0; j < 4; ++j) { const int c = 4 * F.lane + 256 * j;
            const f32x4 g = *(const f32x4*)(g1 + c), sh = *(const f32x4*)(mv + c), scl = *(const f32x4*)(mv + D + c);
            v[j] = v[j] * rstd * g * (scl + 1.0f) + sh;
            amax = fmaxf(amax, fmaxf(fmaxf(fabsf(v[j][0]), fabsf(v[j][1])), fmaxf(fabsf(v[j][2]), fabsf(v[j][3])))); }
#pragma unroll
        for (int o = 1; o < 64; o <<= 1) amax = fmaxf(amax, __shfl_xor(amax, o));
        const float sc = amax > 0.f ? amax * (1.0f / 127.0f) : 1.0f, inv = 1.0f / sc;
#pragma unroll
        for (int j = 0; j < 4; ++j) { const int c = 4 * F.lane + 256 * j;
            const int q0 = (int)rintf(v[j][0] * inv), q1 = (int)rintf(v[j][1] * inv), q2 = (int)rintf(v[j][2] * inv), q3 = (int)rintf(v[j][3] * inv);
            *(unsigned*)(H + (size_t)r * D + c) = (unsigned)(q0 & 255) | ((unsigned)(q1 & 255) << 8) | ((unsigned)(q2 & 255) << 16) | ((unsigned)(q3 & 255) << 24); }
        if (F.lane == 0) HS[r] = sc;
    }
}

constexpr int LRU_U_OFF = 131072, LRU_U_STRIDE = 272;
template <int PASS> __device__ __forceinline__ void lru_phase(const Frame& F, int widx, int nw) {
    const bf16* PAX = (const bf16*)(F.ws + WS_P);
    const bf16* PAG = (const bf16*)(F.ws + WS_P) + PG_STRIDE;
    const bf16* LW = (const bf16*)(F.ws + WS_LRUW);
    float* AGG = (float*)(F.ws + WS_AGG);
    bf16* A1 = (bf16*)(F.ws + WS_A1);
    LAS float* AF = (LAS float*)F.lds;
    LAS unsigned char* UL = F.lds + LRU_U_OFF;
    const int fr = F.lane & 15, fq = F.lane >> 4, w = F.wave;
    const int c8 = (F.tid & 15) * 8, pr = F.tid >> 4;
    for (int vw = widx; vw < 256; vw += nw) {
        const int g = vw & 7, b = (vw >> 3) & 7, q = vw >> 6;
        const int jt0 = PASS == 1 ? 9 * q : 4 + 8 * q, ntile = PASS == 1 ? 9 : 8;
        float cin[8];
#pragma unroll
        for (int i = 0; i < 8; ++i) cin[i] = 0.f;
        if (PASS == 2 && F.wave < 4) {
            const int d = F.wave >> 1, gc = g * 128 + (F.tid & 127);
            const float* aggA = AGG + ((size_t)(0 * 2 + d) * NB + b) * 36 * D; const float* aggH = AGG + ((size_t)(1 * 2 + d) * NB + b) * 36 * D;
            float ca[36], chh[36];
            if (d == 0) {
#pragma unroll
                for (int k = 0; k < 36; ++k) { ca[k] = aggA[(size_t)k * D + gc]; chh[k] = aggH[(size_t)k * D + gc]; }
            } else {
#pragma unroll
                for (int k = 0; k < 36; ++k) { const int sq = k < 4 ? 3 - k : 39 - k; ca[k] = aggA[(size_t)sq * D + gc]; chh[k] = aggH[(size_t)sq * D + gc]; }
            }
            float h = 0.f;
#pragma unroll
            for (int k = 0; k < 36; ++k) { const int sq = d ? (k < 4 ? 3 - k : 39 - k) : k;
#pragma unroll
                for (int i = 0; i < 8; ++i) cin[i] = (sq == jt0 + i) ? h : cin[i];
                h = ca[k] * h + chh[k]; }
        }
        bf16x8 fa[2][4], fx[2][4]; f32x4 bav[2], bxv[2], splv[2];
        const int ch0 = g * 128 + 16 * w + 4 * fq;
#pragma unroll
        for (int d = 0; d < 2; ++d) {
            const bf16* wa = LW + (size_t)((d * 2 + 0) * 8 + g) * 16384 + (size_t)(16 * w + fr) * 128 + fq * 8;
            const bf16* wx = LW + (size_t)((d * 2 + 1) * 8 + g) * 16384 + (size_t)(16 * w + fr) * 128 + fq * 8;
            if (PASS == 1) {
#pragma unroll
            for (int kk = 0; kk < 4; ++kk) { fa[d][kk] = *(const bf16x8*)(wa + kk * 32); fx[d][kk] = *(const bf16x8*)(wx + kk * 32); } }
            bav[d] = *(const f32x4*)(F.in[I_BA] + d * D + ch0) * -1.44269504089f; bxv[d] = *(const f32x4*)(F.in[I_BX] + d * D + ch0) * -1.44269504089f; splv[d] = *(const f32x4*)((const float*)(F.ws + WS_SPL) + d * D + ch0);
        }
#pragma unroll 1
        for (int ti = 0; ti < ntile; ++ti) {
            const int jt = jt0 + ti;
            const bool isctx = jt < 4;
            const int row0 = isctx ? TL + b * CTXL + jt * 64 : b * SEQ + (jt - 4) * 64;
            const int plo = isctx ? -jt * 64 : 0, phi = isctx ? CTXL - 1 - jt * 64 : 63;
            {
                const float* cw = F.in[I_CONVW] + g * 128 + c8; const float* cb = F.in[I_CONVB] + g * 128 + c8;
                u32x4 xv[2][4]; float msk[2][4];
#pragma unroll
                for (int hh = 0; hh < 2; ++hh)
#pragma unroll
                    for (int k = 0; k < 4; ++k) { const int pp = pr + 32 * hh + k - 2; const bool valid = pp >= plo && pp <= phi; const int pc = valid ? pp : 0;
                        msk[hh][k] = valid ? 1.0f : 0.0f; xv[hh][k] = *(const u32x4*)(PAX + (size_t)(row0 + pc) * D + g * 128 + c8); }
                f32x4 w0[4], w1[4];
#pragma unroll
                for (int k = 0; k < 4; ++k) { w0[k] = *(const f32x4*)(cw + k * D); w1[k] = *(const f32x4*)(cw + k * D + 4); }
                const f32x4 b0 = *(const f32x4*)cb, b1 = *(const f32x4*)(cb + 4);
#pragma unroll
                for (int hh = 0; hh < 2; ++hh) { f32x4 o0 = b0, o1 = b1;
#pragma unroll
                    for (int k = 0; k < 4; ++k) { const u32x4 x = xv[hh][k]; const float m = msk[hh][k];
                        o0 += (w0[k] * m) * (f32x4){bflo(x.x), bfhi(x.x), bflo(x.y), bfhi(x.y)}; o1 += (w1[k] * m) * (f32x4){bflo(x.z), bfhi(x.z), bflo(x.w), bfhi(x.w)}; }
                    u32x4 wv; wv.x = pkbf(o0[0], o0[1]); wv.y = pkbf(o0[2], o0[3]); wv.z = pkbf(o1[0], o1[1]); wv.w = pkbf(o1[2], o1[3]);
                    *(LAS u32x4*)(UL + (pr + 32 * hh) * LRU_U_STRIDE + c8 * 2) = wv; }
            }
            u32x4 gg[2];
            if (PASS == 2) {
#pragma unroll
                for (int hh = 0; hh < 2; ++hh) gg[hh] = *(const u32x4*)(PAG + (size_t)(row0 + pr + 32 * hh) * D + g * 128 + c8);
            }
            __syncthreads();
            {
#pragma unroll
                for (int d = 0; d < 2; ++d) {
                    if (PASS == 2) {
                        const bf16* wa = LW + (size_t)((d * 2 + 0) * 8 + g) * 16384 + (size_t)(16 * w + fr) * 128 + fq * 8;
                        const bf16* wx = LW + (size_t)((d * 2 + 1) * 8 + g) * 16384 + (size_t)(16 * w + fr) * 128 + fq * 8;
#pragma unroll
                        for (int kk = 0; kk < 4; ++kk) { fa[d][kk] = *(const bf16x8*)(wa + kk * 32); fx[d][kk] = *(const bf16x8*)(wx + kk * 32); } }
                    LAS float* Ad = AF + (size_t)(2 * d) * 8192; LAS float* Bd = AF + (size_t)(2 * d + 1) * 8192;
#pragma unroll
                    for (int tt = 0; tt < 4; ++tt) { const int t = 16 * tt + fr;
                        bf16x8 ub[4]; f32x4 ga_ = (f32x4){0.f, 0.f, 0.f, 0.f}, gx_ = (f32x4){0.f, 0.f, 0.f, 0.f};
#pragma unroll
                        for (int kk = 0; kk < 4; ++kk) ub[kk] = *(const LAS bf16x8*)(UL + (16 * tt + fr) * LRU_U_STRIDE + kk * 64 + fq * 16);
#pragma unroll
                        for (int kk = 0; kk < 4; ++kk) { ga_ = __builtin_amdgcn_mfma_f32_16x16x32_bf16(fa[d][kk], ub[kk], ga_, 0, 0, 0); gx_ = __builtin_amdgcn_mfma_f32_16x16x32_bf16(fx[d][kk], ub[kk], gx_, 0, 0, 0); }
                        f32x4 ga[4], gx[4]; ga[tt] = ga_; gx[tt] = gx_;
                        const u32x2 uu = *(const LAS u32x2*)(UL + t * LRU_U_STRIDE + (16 * w + 4 * fq) * 2);
                        const float uf[4] = {bflo(uu.x), bfhi(uu.x), bflo(uu.y), bfhi(uu.y)};
                        f32x4 av, bv;
#pragma unroll
                        for (int r = 0; r < 4; ++r) {
                            const float rg = __builtin_amdgcn_rcpf(1.0f + __builtin_amdgcn_exp2f(__builtin_fmaf(ga[tt][r], -1.44269504089f, bav[d][r])));
                            const float ig = __builtin_amdgcn_rcpf(1.0f + __builtin_amdgcn_exp2f(__builtin_fmaf(gx[tt][r], -1.44269504089f, bxv[d][r])));
                            const float t2 = -rg * splv[d][r];
                            const float a = __builtin_amdgcn_exp2f(t2); const float x2 = t2 * 1.38629436112f;
                            const float omx = -x2 * (1.0f + x2 * (0.5f + x2 * (0.16666667f + x2 * (0.041666668f + x2 * (0.0083333338f + x2 * 0.0013888889f)))));
                            av[r] = (PASS == 1) ? t2 : a; bv[r] = __builtin_amdgcn_sqrtf(omx) * ig * uf[r]; }
                        *(LAS f32x4*)(Ad + t * 128 + 16 * w + 4 * fq) = av; *(LAS f32x4*)(Bd + t * 128 + 16 * w + 4 * fq) = bv; }
                }
            }
            __syncthreads();
            if (F.wave < 4) {
                const int d = F.wave >> 1, ch = F.tid & 127, gc = g * 128 + ch;
                LAS float* Ad = AF + (size_t)(2 * d) * 8192 + ch; LAS float* Bd = AF + (size_t)(2 * d + 1) * 8192 + ch;
                if (PASS == 1) {
                    float h = 0.f, ap = 1.f;
#pragma unroll 8
                    for (int s = 0; s < 64; ++s) { const int t = d ? 63 - s : s; const float a = __builtin_amdgcn_exp2f(Ad[t * 128]), bb = Bd[t * 128]; h = a * h + bb; ap *= a; }
                    AGG[(((size_t)(0 * 2 + d) * NB + b) * 36 + jt) * D + gc] = ap; AGG[(((size_t)(1 * 2 + d) * NB + b) * 36 + jt) * D + gc] = h;
                } else {
                    float h = cin[0];
#pragma unroll
                    for (int i = 1; i < 8; ++i) h = (ti == i) ? cin[i] : h;
#pragma unroll 8
                    for (int s = 0; s < 64; ++s) { const int t = d ? 63 - s : s; const float a = Ad[t * 128], bb = Bd[t * 128]; h = a * h + bb; Bd[t * 128] = h; }
                }
            }
            if (PASS == 1 && !isctx) {
                constexpr unsigned dofs[4] = {(unsigned)WS_T1, (unsigned)WS_MM, (unsigned)WS_H2, (unsigned)WS_A2};
#pragma unroll
                for (int hh = 0; hh < 2; ++hh) { const int p = pr + 32 * hh; const unsigned voff = (unsigned)(((row0 + p) * D + g * 128 + c8) * 2);
#pragma unroll
                    for (int k4 = 0; k4 < 4; ++k4) { const LAS float* sp = AF + (size_t)k4 * 8192 + p * 128 + c8;
                        const f32x4 x0 = *(const LAS f32x4*)sp, x1 = *(const LAS f32x4*)(sp + 4);
                        *(u32x4*)(F.ws + (size_t)(dofs[k4] + voff)) = (u32x4){pkbf(x0[0], x0[1]), pkbf(x0[2], x0[3]), pkbf(x1[0], x1[1]), pkbf(x1[2], x1[3])}; } }
            }
            __syncthreads();
            if (PASS == 2) {
#pragma unroll
                for (int hh = 0; hh < 2; ++hh) { const int p = pr + 32 * hh;
                    const LAS float* h0 = AF + 8192 + p * 128 + c8; const LAS float* h1 = AF + 3 * 8192 + p * 128 + c8;
                    const f32x4 x0 = *(const LAS f32x4*)h0, x1 = *(const LAS f32x4*)(h0 + 4), y0 = *(const LAS f32x4*)h1, y1 = *(const LAS f32x4*)(h1 + 4);
                    const u32x4 gv = gg[hh];
                    u32x4 o; o.x = pkbf((x0[0] + y0[0]) * bflo(gv.x), (x0[1] + y0[1]) * bfhi(gv.x)); o.y = pkbf((x0[2] + y0[2]) * bflo(gv.y), (x0[3] + y0[3]) * bfhi(gv.y));
                    o.z = pkbf((x1[0] + y1[0]) * bflo(gv.z), (x1[1] + y1[1]) * bfhi(gv.z)); o.w = pkbf((x1[2] + y1[2]) * bflo(gv.w), (x1[3] + y1[3]) * bfhi(gv.w));
                    *(u32x4*)(A1 + (size_t)(row0 + p) * D + g * 128 + c8) = o; }
                __syncthreads();
            }
        }
    }
}

__device__ __forceinline__ void lru_pass2_stream(const Frame& F, int widx, int nw) {
    const bf16* PAG = (const bf16*)(F.ws + WS_P) + PG_STRIDE;
    const bf16* const src[4] = {(const bf16*)(F.ws + WS_T1), (const bf16*)(F.ws + WS_MM), (const bf16*)(F.ws + WS_H2), (const bf16*)(F.ws + WS_A2)};
    const float* AGG = (const float*)(F.ws + WS_AGG);
    bf16* A1 = (bf16*)(F.ws + WS_A1);
    LAS float* AF = (LAS float*)F.lds;
    const int c8 = (F.tid & 15) * 8, pr = F.tid >> 4;
    for (int vw = widx; vw < 256; vw += nw) {
        const int g = vw & 7, b = (vw >> 3) & 7, q = vw >> 6, jt0 = 4 + 8 * q;
        float cin[8];
#pragma unroll
        for (int i = 0; i < 8; ++i) cin[i] = 0.f;
        if (F.wave < 4) {
            const int d = F.wave >> 1, gc = g * 128 + (F.tid & 127);
            const float* aggA = AGG + ((size_t)(0 * 2 + d) * NB + b) * 36 * D; const float* aggH = AGG + ((size_t)(1 * 2 + d) * NB + b) * 36 * D;
            float ca[36], chh[36];
            if (d == 0) {
#pragma unroll
                for (int k = 0; k < 36; ++k) { ca[k] = aggA[(size_t)k * D + gc]; chh[k] = aggH[(size_t)k * D + gc]; }
            } else {
#pragma unroll
                for (int k = 0; k < 36; ++k) { const int sq = k < 4 ? 3 - k : 39 - k; ca[k] = aggA[(size_t)sq * D + gc]; chh[k] = aggH[(size_t)sq * D + gc]; }
            }
            float h = 0.f;
#pragma unroll
            for (int k = 0; k < 36; ++k) { const int sq = d ? (k < 4 ? 3 - k : 39 - k) : k;
#pragma unroll
                for (int i = 0; i < 8; ++i) cin[i] = (sq == jt0 + i) ? h : cin[i];
                h = ca[k] * h + chh[k]; }
        }
        u32x4 cur[4][2], gg[2];
#define L2_LOAD(TI, DST, GG) do { const int row_ = b * SEQ + (jt0 + (TI) - 4) * 64; \
        _Pragma("unroll") for (int k4 = 0; k4 < 4; ++k4) _Pragma("unroll") for (int hh = 0; hh < 2; ++hh) DST[k4][hh] = *(const u32x4*)(src[k4] + (size_t)(row_ + pr + 32 * hh) * D + g * 128 + c8); \
        _Pragma("unroll") for (int hh = 0; hh < 2; ++hh) GG[hh] = *(const u32x4*)(PAG + (size_t)(row_ + pr + 32 * hh) * D + g * 128 + c8); } while (0)
        L2_LOAD(0, cur, gg);
#pragma unroll 1
        for (int ti = 0; ti < 8; ++ti) {
            const int row0 = b * SEQ + (jt0 + ti - 4) * 64;
#pragma unroll
            for (int k4 = 0; k4 < 4; ++k4)
#pragma unroll
                for (int hh = 0; hh < 2; ++hh) { const u32x4 v = cur[k4][hh]; f32x4 x0 = (f32x4){bflo(v.x), bfhi(v.x), bflo(v.y), bfhi(v.y)}, x1 = (f32x4){bflo(v.z), bfhi(v.z), bflo(v.w), bfhi(v.w)};
                    if ((k4 & 1) == 0) {
#pragma unroll
                        for (int i = 0; i < 4; ++i) { x0[i] = __builtin_amdgcn_exp2f(x0[i]); x1[i] = __builtin_amdgcn_exp2f(x1[i]); } }
                    LAS float* dp = AF + (size_t)k4 * 8192 + (pr + 32 * hh) * 128 + c8; *(LAS f32x4*)dp = x0; *(LAS f32x4*)(dp + 4) = x1; }
            const u32x4 gcur0 = gg[0], gcur1 = gg[1];
            if (ti + 1 < 8) { L2_LOAD(ti + 1, cur, gg); }
            __syncthreads();
            if (F.wave < 4) {
                const int d = F.wave >> 1, ch = F.tid & 127;
                LAS float* Ad = AF + (size_t)(2 * d) * 8192 + ch; LAS float* Bd = AF + (size_t)(2 * d + 1) * 8192 + ch;
                float h = cin[0];
#pragma unroll
                for (int i = 1; i < 8; ++i) h = (ti == i) ? cin[i] : h;
#pragma unroll 8
                for (int s = 0; s < 64; ++s) { const int t = d ? 63 - s : s; const float a = Ad[t * 128], bb = Bd[t * 128]; h = a * h + bb; Bd[t * 128] = h; }
            }
            __syncthreads();
#pragma unroll
            for (int hh = 0; hh < 2; ++hh) { const int p = pr + 32 * hh;
                const LAS float* h0 = AF + 8192 + p * 128 + c8; const LAS float* h1 = AF + 3 * 8192 + p * 128 + c8;
                const f32x4 x0 = *(const LAS f32x4*)h0, x1 = *(const LAS f32x4*)(h0 + 4), y0 = *(const LAS f32x4*)h1, y1 = *(const LAS f32x4*)(h1 + 4);
                const u32x4 gv = hh ? gcur1 : gcur0;
                u32x4 o; o.x = pkbf((x0[0] + y0[0]) * bflo(gv.x), (x0[1] + y0[1]) * bfhi(gv.x)); o.y = pkbf((x0[2] + y0[2]) * bflo(gv.y), (x0[3] + y0[3]) * bfhi(gv.y));
                o.z = pkbf((x1[0] + y1[0]) * bflo(gv.z), (x1[1] + y1[1]) * bfhi(gv.z)); o.w = pkbf((x1[2] + y1[2]) * bflo(gv.w), (x1[3] + y1[3]) * bfhi(gv.w));
                *(u32x4*)(A1 + (size_t)(row0 + p) * D + g * 128 + c8) = o; }
            __syncthreads();
        }
#undef L2_LOAD
    }
}

constexpr int HG_QT = 0, HG_KT = 9216, HG_QH = 18432, HG_KHT = 27648, HG_VT = 36864, HG_PS = 55296, HG_ST0 = 64512, HG_ST1 = 82944, HG_SEG = 101376, HG_DEC = 105472;
constexpr int HG_INV = 139264;
constexpr int HS64 = 144;
#define HG_SYNC() asm volatile("s_waitcnt lgkmcnt(0)\n\ts_barrier" ::: "memory")
__device__ __forceinline__ void hgrn_phase(const Frame& F) {
    const bf16* PQ = (const bf16*)(F.ws + WS_P) + 2 * PG_STRIDE;
    const bf16* PV = (const bf16*)(F.ws + WS_P) + 5 * PG_STRIDE;
    LAS unsigned char* L = F.lds;
    const int fr = F.lane & 15, fq = F.lane >> 4, w = F.wave, lane = F.lane;
    if (F.tid < 32) ((LAS float*)(L + HG_INV))[F.tid] = ((const float*)(F.ws + WS_SW1))[32 + F.tid];
    __syncthreads();
    for (int it = F.vcu; it < 256; it += F.G) {
        const int dh = it & 1, dir = (it >> 1) & 1, h = (it >> 2) & 7, b = it >> 5;
        const bf16* PF = (const bf16*)(F.ws + WS_P) + (size_t)(3 + dir) * PG_STRIDE;
        bf16* OUT = (bf16*)(F.ws + (dir ? (dh ? WS_X1 + 32 * MiB : WS_OB) : (dh ? WS_X1 : WS_OF)));
        const int dp = lane & 31, ph = lane >> 5, d0 = 2 * dp;
        const int dcol = h * 128 + 64 * dh + d0;
        float lb0, lb1;
        { const float* ll = F.in[I_LBL]; const float a0 = ll[dcol], a1 = ll[dcol + 1], c0 = ll[D + dcol], c1 = ll[D + dcol + 1];
          lb0 = 1.0f / (1.0f + __expf(c0 - a0)); lb1 = 1.0f / (1.0f + __expf(c1 - a1)); }
        f32x4 S[4];
#pragma unroll
        for (int j = 0; j < 4; ++j) S[j] = (f32x4){0.f, 0.f, 0.f, 0.f};
#define HG_BASE(ci) ((ci) >= 4 ? b * SEQ + 64 * (dir ? 31 - ((ci) - 4) : ((ci) - 4)) : TL + b * CTXL + 64 * (dir ? 3 - (ci) : (ci)))
#define HG_LOAD(ci, FR, QR, VR) do { const int base_ = HG_BASE(ci); const bool lat_ = (ci) >= 4; \
        _Pragma("unroll") for (int i = 0; i < 4; ++i) { const int p_ = 8 * w + 4 * ph + i; const size_t ro_ = (size_t)(base_ + (dir ? 63 - p_ : p_)) * D + dcol; \
            FR[i] = *(const unsigned*)(PF + ro_); QR[i] = lat_ ? *(const unsigned*)(PQ + ro_) : 0u; } \
        _Pragma("unroll") for (int i = 0; i < 8; ++i) { const int p_ = 8 * w + i; VR[i] = *(const unsigned*)(PV + (size_t)(base_ + (dir ? 63 - p_ : p_)) * D + h * 128 + 2 * lane); } } while (0)
        unsigned fraw[4], qraw[4], vraw[8];
        HG_LOAD(0, fraw, qraw, vraw);
        unsigned fn[4], qn[4], vn[8];
        HG_LOAD(1, fn, qn, vn);
        float cs[4][2], kk[4][2];
#define HG_E1(FR) do { float run0_ = 0.f, run1_ = 0.f; \
        _Pragma("unroll") for (int i = 0; i < 4; ++i) { \
            const float f0_ = lb0 + (1.0f - lb0) * fast_sigmoid(bflo(FR[i])), f1_ = lb1 + (1.0f - lb1) * fast_sigmoid(bfhi(FR[i])); \
            run0_ += __builtin_amdgcn_logf(f0_); run1_ += __builtin_amdgcn_logf(f1_); \
            cs[i][0] = run0_; cs[i][1] = run1_; kk[i][0] = 1.0f - f0_; kk[i][1] = 1.0f - f1_; } \
        *(LAS f32x2*)(L + HG_SEG + ((2 * w + ph) * 64 + d0) * 4) = (f32x2){run0_, run1_}; } while (0)
        HG_E1(fraw);
        int pitem = -1;
        LAS unsigned char* fscr = L + 106496 + w * 4096;
        for (int ci = 0; ci < 36; ++ci) {
            const bool lat = ci >= 4;
            const int base = HG_BASE(ci);
            unsigned f2[4], q2[4], v2[8];
#pragma unroll
            for (int i = 0; i < 4; ++i) { f2[i] = 0u; q2[i] = 0u; }
#pragma unroll
            for (int i = 0; i < 8; ++i) v2[i] = 0u;
            const int fitem = ci * ((F.G < 256 ? F.G : 256) * NWAVES) + F.vcu * NWAVES + w;
            const bool fdo = fitem < MOE_ITEMS && it < F.G;
            if (pitem >= 0) { asm volatile("s_waitcnt vmcnt(0)" ::: "memory"); MoeItem pm_ = moe_item<false>(F, pitem); pm_.inv = ((const LAS float*)(L + HG_INV))[(pitem >> 11) & 31]; moe_dma_finish(pm_, lane, fscr); }
            if (ci + 2 < 36) { HG_LOAD(ci + 2, f2, q2, v2); }
            if (fdo) { moe_dma_issue(moe_item<false>(F, fitem), lane, fscr); }
            pitem = fdo ? fitem : -1;
            const int sidx = 2 * w + ph;
            HG_SYNC();
            float off0 = 0.f, off1 = 0.f, mid0 = 0.f, mid1 = 0.f, end0 = 0.f, end1 = 0.f;
            f32x2 sgv[16];
#pragma unroll
            for (int ww = 0; ww < 16; ++ww) sgv[ww] = *(const LAS f32x2*)(L + HG_SEG + (ww * 64 + d0) * 4);
            asm volatile("s_waitcnt lgkmcnt(0)" ::: "memory");
#pragma unroll
            for (int ww = 0; ww < 16; ++ww) { const f32x2 sg = sgv[ww];
                if (ww < sidx) { off0 += sg.x; off1 += sg.y; } if (ww < 8) { mid0 += sg.x; mid1 += sg.y; } end0 += sg.x; end1 += sg.y; }
            const float emid0 = __builtin_amdgcn_exp2f(mid0), emid1 = __builtin_amdgcn_exp2f(mid1);
            const float eem0 = __builtin_amdgcn_exp2f(end0 - mid0), eem1 = __builtin_amdgcn_exp2f(end1 - mid1);
            unsigned kh0[2], kh1[2];
            {
                float em[4][2], kt[4][2];
#pragma unroll
                for (int i = 0; i < 4; ++i) { const float g0 = off0 + cs[i][0], g1 = off1 + cs[i][1];
                    em[i][0] = __builtin_amdgcn_exp2f(g0 - mid0); em[i][1] = __builtin_amdgcn_exp2f(g1 - mid1);
                    kt[i][0] = kk[i][0] * __builtin_amdgcn_rcpf(em[i][0]); kt[i][1] = kk[i][1] * __builtin_amdgcn_rcpf(em[i][1]); }
                unsigned wq[4], wk[4], wh[4];
#pragma unroll
                for (int i = 0; i < 4; ++i) { const float qt0 = bflo(qraw[i]) * em[i][0], qt1 = bfhi(qraw[i]) * em[i][1];
                    wq[i] = pkbf(qt0, qt1); wk[i] = pkbf(kt[i][0], kt[i][1]); wh[i] = pkbf(qt0 * emid0, qt1 * emid1); }
                if (lat) {
#pragma unroll
                    for (int i = 0; i < 4; ++i) { const int p = 8 * w + 4 * ph + i;
                        *(LAS unsigned*)(L + HG_QT + p * HS64 + d0 * 2) = wq[i]; *(LAS unsigned*)(L + HG_KT + p * HS64 + d0 * 2) = wk[i]; *(LAS unsigned*)(L + HG_QH + p * HS64 + d0 * 2) = wh[i]; }
                }
                kh0[0] = pkbf(kt[0][0] * eem0, kt[1][0] * eem0); kh0[1] = pkbf(kt[2][0] * eem0, kt[3][0] * eem0);
                kh1[0] = pkbf(kt[0][1] * eem1, kt[1][1] * eem1); kh1[1] = pkbf(kt[2][1] * eem1, kt[3][1] * eem1);
            }
            const int spos = 32 * (w >> 2) + 16 * (w & 1) + 4 * ((w >> 1) & 1);
            *(LAS u32x2*)(L + HG_KHT + d0 * HS64 + (spos + 8 * ph) * 2) = (u32x2){kh0[0], kh0[1]};
            *(LAS u32x2*)(L + HG_KHT + (d0 + 1) * HS64 + (spos + 8 * ph) * 2) = (u32x2){kh1[0], kh1[1]};
            if (sidx == 0) *(LAS f32x2*)(L + HG_DEC + d0 * 4) = (f32x2){emid0 * eem0, emid1 * eem1};
            { u32x4 lo, hi;
              lo.x = (vraw[0] & 0xffffu) | (vraw[1] << 16); lo.y = (vraw[2] & 0xffffu) | (vraw[3] << 16); lo.z = (vraw[4] & 0xffffu) | (vraw[5] << 16); lo.w = (vraw[6] & 0xffffu) | (vraw[7] << 16);
              hi.x = (vraw[0] >> 16) | (vraw[1] & 0xffff0000u); hi.y = (vraw[2] >> 16) | (vraw[3] & 0xffff0000u); hi.z = (vraw[4] >> 16) | (vraw[5] & 0xffff0000u); hi.w = (vraw[6] >> 16) | (vraw[7] & 0xffff0000u);
              *(LAS u32x2*)(L + HG_VT + (2 * lane) * HS64 + spos * 2) = (u32x2){lo.x, lo.y}; *(LAS u32x2*)(L + HG_VT + (2 * lane) * HS64 + (spos + 8) * 2) = (u32x2){lo.z, lo.w};
              *(LAS u32x2*)(L + HG_VT + (2 * lane + 1) * HS64 + spos * 2) = (u32x2){hi.x, hi.y}; *(LAS u32x2*)(L + HG_VT + (2 * lane + 1) * HS64 + (spos + 8) * 2) = (u32x2){hi.z, hi.w}; }
            HG_SYNC();
            const int stoff = (ci & 1) ? HG_ST1 : HG_ST0, stnext = (ci & 1) ? HG_ST0 : HG_ST1;
            if (lat) {
                const int pt = w >> 1;
                bf16x8 ps[2], qh[2];
                {
                    bf16x8 qt[2];
#pragma unroll
                    for (int kq = 0; kq < 2; ++kq) { qt[kq] = *(const LAS bf16x8*)(L + HG_QT + (16 * pt + fr) * HS64 + kq * 64 + fq * 16); qh[kq] = *(const LAS bf16x8*)(L + HG_QH + (16 * pt + fr) * HS64 + kq * 64 + fq * 16); }
                    f32x4 sc[4];
#pragma unroll
                    for (int st = 0; st < 4; ++st) { sc[st] = (f32x4){0.f, 0.f, 0.f, 0.f};
#pragma unroll
                        for (int kq = 0; kq < 2; ++kq) { const bf16x8 xa = *(const LAS bf16x8*)(L + HG_KT + (16 * st + fr) * HS64 + kq * 64 + fq * 16);
                            sc[st] = __builtin_amdgcn_mfma_f32_16x16x32_bf16(xa, qt[kq], sc[st], 0, 0, 0); }
                        const int pp = 16 * pt + fr, s0 = 16 * st + 4 * fq;
#pragma unroll
                        for (int r = 0; r < 4; ++r) sc[st][r] = (s0 + r <= pp) ? sc[st][r] : 0.f; }
#pragma unroll
                    for (int kq = 0; kq < 2; ++kq) { const u32x4 t4 = (u32x4){pkbf(sc[2 * kq][0], sc[2 * kq][1]), pkbf(sc[2 * kq][2], sc[2 * kq][3]), pkbf(sc[2 * kq + 1][0], sc[2 * kq + 1][1]), pkbf(sc[2 * kq + 1][2], sc[2 * kq + 1][3])};
                        ps[kq] = __builtin_bit_cast(bf16x8, t4); }
                }
                const int p = 16 * pt + fr, tok = base + (dir ? 63 - p : p);
#pragma unroll
                for (int j = 0; j < 4; ++j) { const int et = (w & 1) * 4 + j;
                    f32x4 a = (f32x4){0.f, 0.f, 0.f, 0.f};
#pragma unroll
                    for (int kq = 0; kq < 2; ++kq) { const bf16x8 xa = *(const LAS bf16x8*)(L + HG_VT + (16 * et + fr) * HS64 + kq * 64 + fq * 16);
                        a = __builtin_amdgcn_mfma_f32_16x16x32_bf16(xa, ps[kq], a, 0, 0, 0); }
#pragma unroll
                    for (int kq = 0; kq < 2; ++kq) { const bf16x8 xa = *(const LAS bf16x8*)(L + stoff + (16 * et + fr) * HS64 + kq * 64 + fq * 16);
                        a = __builtin_amdgcn_mfma_f32_16x16x32_bf16(xa, qh[kq], a, 0, 0, 0); }
                    u32x2 wv; wv.x = pkbf(a[0], a[1]); wv.y = pkbf(a[2], a[3]);
                    *(u32x2*)(OUT + (size_t)tok * D + h * 128 + 16 * et + 4 * fq) = wv; }
            }
            { const int dt = w & 3;
              const f32x4 dc = *(const LAS f32x4*)(L + HG_DEC + (16 * dt + 4 * fq) * 4);
              bf16x8 xa[2];
#pragma unroll
              for (int kq = 0; kq < 2; ++kq) xa[kq] = *(const LAS bf16x8*)(L + HG_KHT + (16 * dt + fr) * HS64 + kq * 64 + fq * 16);
#pragma unroll
              for (int j = 0; j < 4; ++j) { const int et = (w >> 2) * 4 + j; S[j] = S[j] * dc;
#pragma unroll
                  for (int kq = 0; kq < 2; ++kq) { const bf16x8 yb = *(const LAS bf16x8*)(L + HG_VT + (16 * et + fr) * HS64 + kq * 64 + fq * 16);
                      S[j] = __builtin_amdgcn_mfma_f32_16x16x32_bf16(xa[kq], yb, S[j], 0, 0, 0); }
                  u32x2 wv; wv.x = pkbf(S[j][0], S[j][1]); wv.y = pkbf(S[j][2], S[j][3]);
                  *(LAS u32x2*)(L + stnext + (16 * et + fr) * HS64 + (16 * dt + 4 * fq) * 2) = wv; } }
            if (ci + 1 < 36) { HG_E1(fn); }
#pragma unroll
            for (int i = 0; i < 4; ++i) { fraw[i] = fn[i]; qraw[i] = qn[i]; fn[i] = f2[i]; qn[i] = q2[i]; }
#pragma unroll
            for (int i = 0; i < 8; ++i) { vraw[i] = vn[i]; vn[i] = v2[i]; }
        }
        if (pitem >= 0) { asm volatile("s_waitcnt vmcnt(0)" ::: "memory"); MoeItem pm_ = moe_item<false>(F, pitem); pm_.inv = ((const LAS float*)(L + HG_INV))[(pitem >> 11) & 31]; moe_dma_finish(pm_, lane, fscr); }
        HG_SYNC();
#undef HG_BASE
#undef HG_LOAD
#undef HG_E1
    }
}

__device__ __forceinline__ void p5_readout(const Frame& F) {
    const int gw = F.vcu * NWAVES + F.wave, NGW = F.G * NWAVES;
    const bf16* OFp = (const bf16*)(F.ws + WS_OF); const bf16* OBp = (const bf16*)(F.ws + WS_OB); const bf16* OF1 = (const bf16*)(F.ws + WS_X1); const bf16* OB1 = (const bf16*)(F.ws + WS_X1 + 32 * MiB);
    const bf16* SG = (const bf16*)(F.ws + WS_P) + 6 * PG_STRIDE; bf16* A2 = (bf16*)(F.ws + WS_A2);
    const float* gn = F.in[I_HGG];
    const int c0 = 16 * F.lane, e0 = c0 & 127;
    for (int r = gw; r < TL; r += NGW) {
        const size_t off = (size_t)r * D + c0;
        const u32x4 a0 = *(const u32x4*)(OFp + off), a1 = *(const u32x4*)(OFp + off + 8), b0 = *(const u32x4*)(OBp + off), b1 = *(const u32x4*)(OBp + off + 8);
        const u32x4 c0v = *(const u32x4*)(OF1 + off), c1v = *(const u32x4*)(OF1 + off + 8), d0v = *(const u32x4*)(OB1 + off), d1v = *(const u32x4*)(OB1 + off + 8);
        const u32x4 s0 = *(const u32x4*)(SG + off), s1 = *(const u32x4*)(SG + off + 8);
        const unsigned aa[8] = {a0.x, a0.y, a0.z, a0.w, a1.x, a1.y, a1.z, a1.w}, bb[8] = {b0.x, b0.y, b0.z, b0.w, b1.x, b1.y, b1.z, b1.w}, sg[8] = {s0.x, s0.y, s0.z, s0.w, s1.x, s1.y, s1.z, s1.w};
        const unsigned cc[8] = {c0v.x, c0v.y, c0v.z, c0v.w, c1v.x, c1v.y, c1v.z, c1v.w}, dd[8] = {d0v.x, d0v.y, d0v.z, d0v.w, d1v.x, d1v.y, d1v.z, d1v.w};
        float o[16]; float ss = 0.f;
#pragma unroll
        for (int q = 0; q < 8; ++q) { o[2 * q] = (bflo(aa[q]) + bflo(cc[q])) + (bflo(bb[q]) + bflo(dd[q])); o[2 * q + 1] = (bfhi(aa[q]) + bfhi(cc[q])) + (bfhi(bb[q]) + bfhi(dd[q])); ss += o[2 * q] * o[2 * q] + o[2 * q + 1] * o[2 * q + 1]; }
        ss += __shfl_xor(ss, 1); ss += __shfl_xor(ss, 2); ss += __shfl_xor(ss, 4);
        const float rstd = 1.0f / sqrtf(ss * (1.0f / 128.0f) + EPS);
        unsigned wv[8];
#pragma unroll
        for (int q = 0; q < 8; ++q) wv[q] = pk2(o[2 * q] * rstd * gn[e0 + 2 * q] * bflo(sg[q]), o[2 * q + 1] * rstd * gn[e0 + 2 * q + 1] * bfhi(sg[q]));
        *(u32x4*)(A2 + off) = (u32x4){wv[0], wv[1], wv[2], wv[3]}; *(u32x4*)(A2 + off + 8) = (u32x4){wv[4], wv[5], wv[6], wv[7]};
    }
}

constexpr int RW_STRIDE = 36;
__device__ __forceinline__ void p9_route(const Frame& F) {
    LAS float* RW = (LAS float*)F.lds;
    for (int i = F.tid; i < D * 8; i += 512) { const int k = i >> 3, q = i & 7, slot = ((k & 255) >> 2) + 64 * (4 * (k >> 8) + (k & 3)); *(LAS f32x4*)(RW + slot * RW_STRIDE + 4 * q) = *(const f32x4*)(F.in[I_RW] + k * 32 + 4 * q); }
    __syncthreads();
    const int lane = F.lane;
    const float* X1 = (const float*)(F.ws + WS_X1); const float* mod = (const float*)(F.ws + WS_MOD); unsigned char* H2 = F.ws + WS_H2; float* SCL = (float*)(F.ws + WS_SCL);
    const float* g2 = F.in[I_N2G];
    unsigned* cnt = (unsigned*)(F.ws + WS_CTL) + CW_CNT;
    int* TE = (int*)(F.ws + WS_ROUTE); int* TP = TE + TL * 4; float* TG = (float*)(TP + TL * 4); int* LIST = (int*)(F.ws + WS_LIST);
    LAS unsigned* ALIST = (LAS unsigned*)(F.lds + 147456);
    LAS int* HIST = (LAS int*)(F.lds + 149504); LAS int* BASE = HIST + 32; LAS float* TSC = (LAS float*)(BASE + 32);
    if (F.tid < 32) HIST[F.tid] = 0;
    __syncthreads();
    const int my_e = ((lane >> 5) & 1) * 16 + ((lane >> 4) & 1) * 8 + ((lane >> 3) & 1) * 4 + ((lane >> 2) & 1) * 2 + ((lane >> 1) & 1);
    const float rbias = F.in[I_RB][my_e];
    const int tpw = (TL + F.G - 1) / F.G, t0 = F.vcu * tpw, t1 = (t0 + tpw < TL) ? t0 + tpw : TL;
    int curb = -1; float gk[16], sk[16];
#pragma unroll
    for (int j = 0; j < 16; ++j) { gk[j] = 0.f; sk[j] = 0.f; }
    int n = 0;
    for (int tb = t0 + F.wave; tb < t1; tb += 16, n += 2) {
        const bool has2 = tb + 8 < t1;
        const int tt[2] = {tb, has2 ? tb + 8 : tb};
        if ((tb >> 11) != curb) { curb = tb >> 11; const float* mv = mod + (size_t)curb * NMOD;
#pragma unroll
            for (int j = 0; j < 4; ++j) { const int k = 4 * lane + 256 * j; const f32x4 gv = *(const f32x4*)(g2 + k), m4 = *(const f32x4*)(mv + 4 * D + k), m3 = *(const f32x4*)(mv + 3 * D + k);
#pragma unroll
                for (int i = 0; i < 4; ++i) { gk[4 * j + i] = gv[i] * (1.0f + m4[i]); sk[4 * j + i] = m3[i]; } } }
        float xv[2][16]; float ss[2] = {0.f, 0.f};
#pragma unroll
        for (int u = 0; u < 2; ++u)
#pragma unroll
            for (int j = 0; j < 4; ++j) { const f32x4 v = *(const f32x4*)(X1 + (size_t)tt[u] * D + 4 * lane + 256 * j);
#pragma unroll
                for (int i = 0; i < 4; ++i) { xv[u][4 * j + i] = v[i]; ss[u] += v[i] * v[i]; } }
        float rstd[2];
#pragma unroll
        for (int o = 1; o < 64; o <<= 1) { ss[0] += __shfl_xor(ss[0], o); ss[1] += __shfl_xor(ss[1], o); }
        rstd[0] = 1.0f / sqrtf(ss[0] * (1.0f / D) + EPS); rstd[1] = 1.0f / sqrtf(ss[1] * (1.0f / D) + EPS);
        float am0 = 0.f, am1 = 0.f;
#pragma unroll
        for (int j = 0; j < 16; ++j) { xv[0][j] = xv[0][j] * rstd[0] * gk[j] + sk[j]; xv[1][j] = xv[1][j] * rstd[1] * gk[j] + sk[j]; am0 = fmaxf(am0, fabsf(xv[0][j])); am1 = fmaxf(am1, fabsf(xv[1][j])); }
#pragma unroll
        for (int o = 1; o < 64; o <<= 1) { am0 = fmaxf(am0, __shfl_xor(am0, o)); am1 = fmaxf(am1, __shfl_xor(am1, o)); }
        const float sc0 = am0 > 0.f ? am0 * (1.0f / 127.0f) : 1.0f, sc1 = am1 > 0.f ? am1 * (1.0f / 127.0f) : 1.0f, iv0 = 1.0f / sc0, iv1 = 1.0f / sc1;
        if (lane == 0) { TSC[n * 8 + F.wave] = sc0; TSC[(n + 1) * 8 + F.wave] = sc1; }
        float acc[2][32];
#pragma unroll
        for (int u = 0; u < 2; ++u)
#pragma unroll
            for (int e = 0; e < 32; ++e) acc[u][e] = 0.f;
#pragma unroll
        for (int j = 0; j < 4; ++j) {
            unsigned w0 = 0u, w1 = 0u;
#pragma unroll
            for (int i = 0; i < 4; ++i) { w0 |= (unsigned)((int)rintf(xv[0][4 * j + i] * iv0) & 255) << (8 * i); w1 |= (unsigned)((int)rintf(xv[1][4 * j + i] * iv1) & 255) << (8 * i); }
            *(unsigned*)(H2 + (size_t)tt[0] * D + 4 * lane + 256 * j) = w0; *(unsigned*)(H2 + (size_t)tt[1] * D + 4 * lane + 256 * j) = w1; }
#pragma unroll
        for (int j = 0; j < 16; ++j) { const int k = lane + 64 * j;
            const float hv0 = xv[0][j], hv1 = xv[1][j];
            const LAS float* rw = RW + k * RW_STRIDE;
#pragma unroll
            for (int q = 0; q < 8; ++q) { const f32x4 wv = *(const LAS f32x4*)(rw + 4 * q);
                acc[0][4 * q] += hv0 * wv[0]; acc[0][4 * q + 1] += hv0 * wv[1]; acc[0][4 * q + 2] += hv0 * wv[2]; acc[0][4 * q + 3] += hv0 * wv[3];
                acc[1][4 * q] += hv1 * wv[0]; acc[1][4 * q + 1] += hv1 * wv[1]; acc[1][4 * q + 2] += hv1 * wv[2]; acc[1][4 * q + 3] += hv1 * wv[3]; }
            asm volatile("" ::: "memory"); }
#define RS_STEP(N, MASK) _Pragma("unroll") for (int i = 0; i < (N); ++i) { const bool up = (lane & (MASK)) != 0; \
            const float s0 = up ? acc[0][i] : acc[0][i + (N)], k0 = up ? acc[0][i + (N)] : acc[0][i], s1 = up ? acc[1][i] : acc[1][i + (N)], k1 = up ? acc[1][i + (N)] : acc[1][i]; \
            acc[0][i] = k0 + __shfl_xor(s0, (MASK)); acc[1][i] = k1 + __shfl_xor(s1, (MASK)); }
        RS_STEP(16, 32) RS_STEP(8, 16) RS_STEP(4, 8) RS_STEP(2, 4) RS_STEP(1, 2)
#undef RS_STEP
        float lg[2]; lg[0] = acc[0][0] + __shfl_xor(acc[0][0], 1) + rbias; lg[1] = acc[1][0] + __shfl_xor(acc[1][0], 1) + rbias;
        float tv[2][4]; int te[2][4];
#pragma unroll
        for (int k4 = 0; k4 < 4; ++k4) {
            float bv0 = lg[0], bv1 = lg[1]; int be0 = my_e, be1 = my_e;
#pragma unroll
            for (int o = 1; o < 64; o <<= 1) { const float ov0 = __shfl_xor(bv0, o), ov1 = __shfl_xor(bv1, o); const int oe0 = __shfl_xor(be0, o), oe1 = __shfl_xor(be1, o);
                if (ov0 > bv0 || (ov0 == bv0 && oe0 < be0)) { bv0 = ov0; be0 = oe0; } if (ov1 > bv1 || (ov1 == bv1 && oe1 < be1)) { bv1 = ov1; be1 = oe1; } }
            tv[0][k4] = bv0; te[0][k4] = be0; if (my_e == be0) lg[0] = -3.0e38f;
            tv[1][k4] = bv1; te[1][k4] = be1; if (my_e == be1) lg[1] = -3.0e38f;
        }
#pragma unroll
        for (int u = 0; u < 2; ++u) {
            const bool act_ = (u == 0) || has2;
            const float p1 = __expf(tv[u][1] - tv[u][0]), p2 = __expf(tv[u][2] - tv[u][0]), p3 = __expf(tv[u][3] - tv[u][0]); const float inv = 1.0f / (1.0f + p1 + p2 + p3);
            if (lane < 4 && act_) { const int e = lane == 0 ? te[u][0] : lane == 1 ? te[u][1] : lane == 2 ? te[u][2] : te[u][3];
                const float gt = (lane == 0 ? 1.0f : lane == 1 ? p1 : lane == 2 ? p2 : p3) * inv;
                const int rank = __hip_atomic_fetch_add(HIST + e, 1, __ATOMIC_RELAXED, __HIP_MEMORY_SCOPE_WORKGROUP);
                ALIST[((n + u) * 8 + F.wave) * 4 + lane] = (unsigned)e | ((unsigned)rank << 8);
                TE[tt[u] * 4 + lane] = e; TG[tt[u] * 4 + lane] = gt; }
        }
    }
    __syncthreads();
    if (F.tid < 32) BASE[F.tid] = (int)__hip_atomic_fetch_add(cnt + 64 * F.tid, (unsigned)HIST[F.tid], __ATOMIC_RELAXED, __HIP_MEMORY_SCOPE_AGENT);
    __syncthreads();
    n = 0;
    for (int t = t0 + F.wave; t < t1; t += 8, ++n) {
        if (lane < 4) { const unsigned ent = ALIST[(n * 8 + F.wave) * 4 + lane]; const int e = (int)(ent & 255u), pos = BASE[e] + (int)(ent >> 8);
            LIST[(size_t)e * TL + pos] = t; TP[t * 4 + lane] = pos; SCL[(size_t)e * TL + pos] = TSC[n * 8 + F.wave]; }
    }
    __syncthreads();
}
__device__ __forceinline__ void moe_tables(const Frame& F, volatile LAS int* tab) {
    if (F.tid < 64) {
        const unsigned* cnt = (const unsigned*)(F.ws + WS_CTL) + CW_CNT; const int e = F.tid & 31;
        const int n = (int)__hip_atomic_load(cnt + 64 * e, __ATOMIC_RELAXED, __HIP_MEMORY_SCOPE_AGENT);
        const int t = (n + 255) >> 8; int run = t;
#pragma unroll
        for (int o = 1; o < 32; o <<= 1) { const int v = __shfl_up(run, o); if (e >= o) run += v; }
        if (F.tid < 32) { tab[e] = run - t; tab[64 + e] = n; if (e == 31) tab[32] = run; }
    }
    __syncthreads();
}
__device__ __forceinline__ void p12_final(const Frame& F, volatile LAS int* tab) {
    const int gw = F.vcu * NWAVES + F.wave, NGW = F.G * NWAVES, lane = F.lane;
    const float* X1 = (const float*)(F.ws + WS_X1); const float* mod = (const float*)(F.ws + WS_MOD); const bf16* Y = (const bf16*)(F.ws + WS_Y);
    const int* TE = (const int*)(F.ws + WS_ROUTE); const int* TP = TE + TL * 4; const float* TG = (const float*)(TP + TL * 4);
    const float* fg = F.in[I_FG];
    f32x4 fgv[4];
#pragma unroll
    for (int j = 0; j < 4; ++j) fgv[j] = *(const f32x4*)(fg + 4 * lane + 256 * j);
    for (int tb = gw; tb < TL; tb += 2 * NGW) {
        const bool has2 = tb + NGW < TL;
        const int tt[2] = {tb, has2 ? tb + NGW : tb};
        size_t yoff[2][4]; float gt[2][4];
#pragma unroll
        for (int u = 0; u < 2; ++u)
#pragma unroll
            for (int k4 = 0; k4 < 4; ++k4) { const int e = TE[tt[u] * 4 + k4], pos = TP[tt[u] * 4 + k4]; gt[u][k4] = TG[tt[u] * 4 + k4]; yoff[u][k4] = ((size_t)tab[e] * 256 + pos) * D + 4 * lane; }
        f32x4 xa[2][4], gm[2][4]; u32x2 yv[2][4][4];
#pragma unroll
        for (int u = 0; u < 2; ++u) { const float* mv = mod + (size_t)(tt[u] >> 11) * NMOD + 5 * D;
#pragma unroll
            for (int j = 0; j < 4; ++j) { xa[u][j] = *(const f32x4*)(X1 + (size_t)tt[u] * D + 4 * lane + 256 * j); gm[u][j] = *(const f32x4*)(mv + 4 * lane + 256 * j);
#pragma unroll
                for (int k4 = 0; k4 < 4; ++k4) yv[u][k4][j] = *(const u32x2*)(Y + yoff[u][k4] + 256 * j); } }
#pragma unroll
        for (int u = 0; u < 2; ++u) {
            f32x4 xv[4]; float ss = 0.f;
#pragma unroll
            for (int j = 0; j < 4; ++j) { f32x4 m = (f32x4){0.f, 0.f, 0.f, 0.f};
#pragma unroll
                for (int k4 = 0; k4 < 4; ++k4) { const u32x2 y = yv[u][k4][j]; const float g = gt[u][k4]; m += (f32x4){bflo(y.x), bfhi(y.x), bflo(y.y), bfhi(y.y)} * g; }
                xv[j] = xa[u][j] + gm[u][j] * m; ss += (xv[j][0] * xv[j][0] + xv[j][1] * xv[j][1]) + (xv[j][2] * xv[j][2] + xv[j][3] * xv[j][3]); }
            const float rstd = 1.0f / sqrtf(wave_sum(ss) * (1.0f / D) + EPS);
            if (u == 0 || has2) {
#pragma unroll
                for (int j = 0; j < 4; ++j) *(f32x4*)(F.out + (size_t)tt[u] * D + 4 * lane + 256 * j) = xv[j] * rstd * fgv[j]; }
        }
    }
}
__global__ void __launch_bounds__(NWAVES * 64, 2) fwd(Args args) {
    extern __shared__ __attribute__((aligned(16))) unsigned char lds[];
    Frame F;
    F.lds = (LAS unsigned char*)lds; F.tid = threadIdx.x; F.lane = F.tid & 63; F.wave = __builtin_amdgcn_readfirstlane(F.tid >> 6);
    F.G = gridDim.x; { const int bx = blockIdx.x; F.vcu = (F.G % 8 == 0) ? (bx % 8) * (F.G / 8) + bx / 8 : bx; }
    F.ws = args.ws; F.in = args.in; F.out = args.out;
    volatile LAS unsigned* MISC = (volatile LAS unsigned*)(F.lds + LDS_MISC);
    volatile LAS int* TAB = (volatile LAS int*)(F.lds + LDS_MISC + 64);
    for (int u = F.tid; u < (LDS_BYTES - LDS_MISC) / 4; u += NWAVES * 64) MISC[u] = 0u;
    __syncthreads();
    unsigned* ctl = (unsigned*)(F.ws + WS_CTL);
    XcdBarrier bar; bar.bar = ctl + CW_BAR; bar.x = 0; bar.st = nullptr;
    if (MK_N_LAUNCHES == 1) bar = xcd_barrier_post(ctl + CW_BAR, MISC);
#define GRID_BAR() do { if (MK_N_LAUNCHES == 1) xcd_barrier(bar); } while (0)
    const int lo = args.ph_lo, hi = args.ph_hi;
#ifndef PH_MASK
#define PH_MASK 0x1fff
#endif
#define IN(k) (((PH_MASK >> (k)) & 1) && lo <= (k) && (k) < hi)
#define BOTH(k) (IN(k) && IN((k) + 1))
    const int cid = (int)blockIdx.x;

#ifndef DUP_MASK
#define DUP_MASK 0
#endif
#define REPS(k) ((((DUP_MASK) >> (k)) & 1) ? 2 : 1)
#define REP_LOOP(k) _Pragma("unroll") for (int rep_ = 0; rep_ < REPS(k); ++rep_)
#define REP_SEP(k) do { if (rep_ + 1 < REPS(k)) { GRID_BAR(); if ((k) == 9) { if (blockIdx.x == 0 && F.tid < 32) __hip_atomic_store(ctl + CW_CNT + 64 * F.tid, 0u, __ATOMIC_RELAXED, __HIP_MEMORY_SCOPE_AGENT); GRID_BAR(); } } } while (0)
    if (IN(0)) { REP_LOOP(0) { p0_prologue(F); REP_SEP(0); } if (BOTH(0)) GRID_BAR(); }
    if (IN(1)) { REP_LOOP(1) { p1_norm(F); REP_SEP(1); } if (BOTH(1)) GRID_BAR(); }
    if (IN(2)) {
        SchedInproj S{(const char*)(F.ws + WS_H), (const char*)(F.ws + WS_WIN), F.G, cid};
        EpiInproj E{(bf16*)(F.ws + WS_P), (const float*)(F.ws + WS_HS), (const float*)(F.ws + WS_WINS)};
        SchedCached<SchedInproj> SC{S, F.lds}; SC.init(F.tid);
        REP_LOOP(2) { pg8::gemm_phase<EpiInproj, SchedCached<SchedInproj>, true, true>(F.lds, D, SC, E); REP_SEP(2); }
        if (F.G != 256) {
            LAS float* scr = (LAS float*)(F.lds + F.wave * 16384);
            const int FW = (F.G < 256 ? F.G : 256) * NWAVES;
            for (int it = 36 * FW + F.vcu * NWAVES + F.wave; it < MOE_ITEMS; it += F.G * NWAVES) { const MoeItem m = moe_item(F, it); float tv[16]; moe_conv_issue(m, F.lane, tv); moe_conv_finish(m, F.lane, tv, scr); }
            __syncthreads();
        }
        if (F.G == 256 && cid >= 128) {
            LAS float* scr = (LAS float*)(F.lds + F.wave * 16384);
            const int first = 36 * 256 * NWAVES + (cid - 128) * NWAVES + F.wave, stride = 128 * NWAVES;
            float tv[16], tn[16]; MoeItem m = moe_item(F, first < MOE_ITEMS ? first : 0), mn = m;
            if (first < MOE_ITEMS) moe_conv_issue(m, F.lane, tv);
            for (int it = first; it < MOE_ITEMS; it += stride) {
                const bool more = it + stride < MOE_ITEMS;
                if (more) { mn = moe_item(F, it + stride); moe_conv_issue(mn, F.lane, tn); }
                moe_conv_finish(m, F.lane, tv, scr);
                m = mn;
#pragma unroll
                for (int i = 0; i < 16; ++i) tv[i] = tn[i];
            }
            __syncthreads();
        }
        if (BOTH(2)) GRID_BAR();
    }
    if (IN(3)) { REP_LOOP(3) { lru_phase<1>(F, F.vcu, F.G); REP_SEP(3); } if (BOTH(3)) GRID_BAR(); }
    if (IN(4)) { REP_LOOP(13) { hgrn_phase(F); REP_SEP(13); } REP_LOOP(14) { lru_pass2_stream(F, F.vcu, F.G); REP_SEP(14); } if (BOTH(4)) GRID_BAR(); }
    if (IN(5)) {
        SchedSq S{(const char*)(F.ws + WS_A1), (const char*)(F.ws + WS_WBA), F.G, cid};
        EpiMerge<0> E{(bf16*)(F.ws + WS_T1), (const bf16*)(F.ws + WS_P) + 7 * PG_STRIDE, nullptr};
        REP_LOOP(6) { pg8::gemm_phase<EpiMerge<0>, SchedSq, false>(F.lds, D, S, E); REP_SEP(6); }
    }
    if (IN(6)) { REP_LOOP(5) { p5_readout(F); REP_SEP(5); } if (BOTH(6)) GRID_BAR(); }
    if (IN(7)) {
        SchedSq S{(const char*)(F.ws + WS_A2), (const char*)(F.ws + WS_WBB), F.G, cid};
        EpiMerge<1> E{(bf16*)(F.ws + WS_MM), (const bf16*)(F.ws + WS_P) + 8 * PG_STRIDE, (const bf16*)(F.ws + WS_T1)};
        REP_LOOP(7) { pg8::gemm_phase<EpiMerge<1>, SchedSq, false>(F.lds, D, S, E); REP_SEP(7); }
        if (BOTH(7)) GRID_BAR();
    }
    if (IN(8)) {
        SchedSq S{(const char*)(F.ws + WS_MM), (const char*)(F.ws + WS_WOUT), F.G, cid};
        EpiX1 E{(float*)(F.ws + WS_X1), F.in[I_X], (const float*)(F.ws + WS_MOD)};
        REP_LOOP(8) { pg8::gemm_phase<EpiX1, SchedSq, false>(F.lds, D, S, E); REP_SEP(8); }
        if (BOTH(8)) GRID_BAR();
    }
    if (IN(9)) { REP_LOOP(9) { p9_route(F); REP_SEP(9); } if (BOTH(9)) GRID_BAR(); }
    if (IN(10)) {
        moe_tables(F, TAB);
        SchedMoe<8, true> S{(const char*)(F.ws + WS_H2), (const char*)(F.ws + WS_W1), (const int*)(F.ws + WS_LIST), TAB, F.G, F.vcu, D};
        EpiAct E{(bf16*)(F.ws + WS_ACT), F.in[I_B1], (const float*)(F.ws + WS_SCL), (const float*)(F.ws + WS_SW1)};
        REP_LOOP(10) { pg8::gemm_phase<EpiAct, SchedMoe<8, true>, true, true>(F.lds, D, S, E); REP_SEP(10); }
        if (BOTH(10)) GRID_BAR();
    }
    if (IN(11)) {
        moe_tables(F, TAB);
        SchedMoe<4, false> S{(const char*)(F.ws + WS_ACT), (const char*)(F.ws + WS_W2), nullptr, TAB, F.G, F.vcu, 2 * D};
        EpiY E{(bf16*)(F.ws + WS_Y), F.in[I_B2]};
        SchedCached<SchedMoe<4, false>> SC{S, F.lds}; SC.init(F.tid);
        REP_LOOP(11) { pg8::gemm_phase<EpiY, SchedCached<SchedMoe<4, false>>, true>(F.lds, D, SC, E); REP_SEP(11); }
        if (BOTH(11)) GRID_BAR();
    }
    if (IN(12)) { moe_tables(F, TAB); REP_LOOP(12) { p12_final(F, TAB); REP_SEP(12); } }
#undef IN
#undef BOTH
#undef GRID_BAR
}

extern "C" void kernel_launch(void* const* d_in, const int* in_sizes, int n_in, void* d_out, int out_size, void* d_ws, size_t ws_size, hipStream_t stream) {
    static int grid = 0;
    if (grid == 0) {
        if (n_in != 28 || in_sizes[0] != TL * D || out_size != TL * D || ws_size < WS_END) { fprintf(stderr, "kernel_launch: unexpected shapes (n_in %d, in0 %d, out %d, ws %zu)\n", n_in, n_in > 0 ? in_sizes[0] : -1, out_size, ws_size); grid = -1; return; }
        int dev = 0, cus = 0, per_cu = 0;
        if (hipGetDevice(&dev) != hipSuccess || hipDeviceGetAttribute(&cus, hipDeviceAttributeMultiprocessorCount, dev) != hipSuccess) { grid = -1; return; }
        if (hipFuncSetAttribute((const void*)fwd, hipFuncAttributeMaxDynamicSharedMemorySize, LDS_BYTES) != hipSuccess) { fprintf(stderr, "kernel_launch: hipFuncSetAttribute failed\n"); grid = -1; return; }
        if (hipOccupancyMaxActiveBlocksPerMultiprocessor(&per_cu, (const void*)fwd, NWAVES * 64, LDS_BYTES) != hipSuccess || per_cu < 1) { fprintf(stderr, "kernel_launch: occupancy query reports %d\n", per_cu); }
        (void)hipGetLastError();
        grid = cus;
    }
    if (grid < 0) return;
    if (hipMemsetAsync((char*)d_ws + WS_CTL, 0, CTL_ZERO_BYTES, stream) != hipSuccess) return;
    Args a{};
    for (int i = 0; i < 28; ++i) a.in[i] = (const float*)d_in[i];
    a.out = (float*)d_out; a.ws = (unsigned char*)d_ws;
    if (MK_N_LAUNCHES == 1) {
        a.ph_lo = 0; a.ph_hi = NPH;
        hipLaunchKernelGGL(fwd, dim3(grid), dim3(NWAVES * 64), LDS_BYTES, stream, a);
    } else {
        for (int p = 0; p < NPH; ++p) { a.ph_lo = p; a.ph_hi = p + 1; hipLaunchKernelGGL(fwd, dim3(grid), dim3(NWAVES * 64), LDS_BYTES, stream, a); }
    }
}
```

```cpp
#include <hip/hip_runtime.h>
#include <cstdio>
#include <cstdint>

#ifndef MK_N_LAUNCHES
#define MK_N_LAUNCHES 1
#endif

#define GAS __attribute__((address_space(1)))
#define LAS __attribute__((address_space(3)))
typedef unsigned short bf16;
typedef short bf16x8 __attribute__((ext_vector_type(8)));
typedef float f32x4 __attribute__((ext_vector_type(4)));
typedef float f32x2 __attribute__((ext_vector_type(2)));
typedef unsigned u32x4 __attribute__((ext_vector_type(4)));
typedef unsigned u32x2 __attribute__((ext_vector_type(2)));
typedef int i32x4 __attribute__((ext_vector_type(4)));

constexpr int NB = 8, SEQ = 2048, CTXL = 256, D = 1024;
constexpr int TL = NB * SEQ;
constexpr int TC = NB * CTXL;
constexpr int TT = TL + TC;
constexpr int NMOD = 6 * D;
constexpr int NE = 32;
constexpr float EPS = 1e-6f;
constexpr int NPH = 13;
constexpr int NWAVES = 8;

constexpr size_t MiB = 1u << 20;
constexpr size_t WS_CTL = 0, CTL_ZERO_BYTES = 1 * MiB;
constexpr size_t WS_MOD = 1 * MiB;
constexpr size_t WS_SPL = 1 * MiB + 512 * 1024;
constexpr size_t WS_ROUTE = 2 * MiB;
constexpr size_t WS_LIST = 3 * MiB;
constexpr size_t WS_AGG = 5 * MiB;
constexpr size_t WS_LRUW = 10 * MiB;
constexpr size_t WS_WBA = 12 * MiB, WS_WBB = 14 * MiB, WS_WOUT = 16 * MiB;
constexpr size_t WS_WIN = 18 * MiB;
constexpr size_t WS_W1 = 36 * MiB;
constexpr size_t WS_W2 = 164 * MiB;
constexpr size_t WS_H = 228 * MiB;
constexpr size_t WS_HS = 248 * MiB;
constexpr size_t WS_WINS = 30 * MiB;
constexpr size_t WS_P = 264 * MiB;
constexpr size_t PG_STRIDE = (size_t)TT * D;
constexpr size_t WS_A1 = 588 * MiB, WS_OF = 620 * MiB, WS_OB = 652 * MiB, WS_A2 = 684 * MiB, WS_T1 = 716 * MiB, WS_MM = 748 * MiB;
constexpr size_t WS_X1 = 780 * MiB;
constexpr size_t WS_H2 = 844 * MiB;
constexpr size_t WS_H2S = 864 * MiB;
constexpr size_t WS_SCL = 32 * MiB;
constexpr size_t WS_SW1 = 1 * MiB + 768 * 1024;
constexpr size_t WS_END = 876 * MiB;
constexpr size_t WS_ACT = WS_P;
constexpr size_t WS_Y = WS_P + 160 * MiB;
static_assert(WS_Y + (size_t)73728 * 1024 * 2 <= WS_A1, "overlay");
constexpr int CW_BAR = 4096;
constexpr int CW_CNT = 16384;

constexpr int RING_BYTES = 131072;
constexpr int SCLZ_OFF = 139264;
constexpr int GROW_OFF = 131072;
constexpr int LDS_MISC = 150528;
constexpr int LDS_BYTES = 151552;

#define LDS_WAIT() asm volatile("s_waitcnt lgkmcnt(0)" ::: "memory")
#define VM_WAIT() asm volatile("s_waitcnt vmcnt(0)" ::: "memory")

__device__ __forceinline__ float bf2f(unsigned b) { return __uint_as_float(b << 16); }
__device__ __forceinline__ float bflo(unsigned w) { return __uint_as_float(w << 16); }
__device__ __forceinline__ float bfhi(unsigned w) { return __uint_as_float(w & 0xffff0000u); }
typedef __bf16 nbf16x2 __attribute__((ext_vector_type(2)));
__device__ __forceinline__ unsigned f2bf(float f) { return (unsigned)__builtin_bit_cast(unsigned short, (__bf16)f); }
__device__ __forceinline__ unsigned pkbf(float lo, float hi) { nbf16x2 v; v[0] = (__bf16)lo; v[1] = (__bf16)hi; return __builtin_bit_cast(unsigned, v); }
__device__ __forceinline__ unsigned pk2(float lo, float hi) { return pkbf(lo, hi); }
__device__ __forceinline__ float wave_sum(float v) {
#pragma unroll
    for (int o = 1; o < 64; o <<= 1) v += __shfl_xor(v, o);
    return v;
}
__device__ __forceinline__ float fast_sigmoid(float z) { return __builtin_amdgcn_rcpf(1.0f + __builtin_amdgcn_exp2f(-1.44269504089f * z)); }

#define XB_TMO      128
#define XB_XCNT(j)  (256  + 64 * (j))
#define XB_XSUB(j)  (1280 + 64 * (j))
#define XB_XGEN(j)  (2304 + 64 * (j))
#define XB_TOP      3328
#define XB_TOPGEN   3392
#define XCD_BAR_WORDS 3456
#define XB_SPIN_CAP (1u << 18)

__device__ __forceinline__ unsigned xb_ld(unsigned* p)              { return __hip_atomic_load(p, __ATOMIC_RELAXED, __HIP_MEMORY_SCOPE_AGENT); }
__device__ __forceinline__ unsigned xb_add(unsigned* p, unsigned v) { return __hip_atomic_fetch_add(p, v, __ATOMIC_RELAXED, __HIP_MEMORY_SCOPE_AGENT); }
__device__ __forceinline__ unsigned xb_xcc_id() { return (unsigned)__builtin_amdgcn_s_getreg((3 << 11) | 20) & 0xFu; }
#define XB_SPIN(cond, bar) do { unsigned _sp = 0; while (cond) { __builtin_amdgcn_s_sleep(1); \
    if ((++_sp & 255u) == 0u) { if (xb_ld(&(bar)[XB_TMO])) break; if (_sp > XB_SPIN_CAP) { atomicAdd(&(bar)[XB_TMO], 1u); break; } } } } while (0)

struct XcdBarrier { unsigned* bar; unsigned x; volatile LAS unsigned* st; };

__device__ __forceinline__ XcdBarrier xcd_barrier_post(unsigned* bar, volatile LAS unsigned* st) {
    XcdBarrier b; b.bar = bar; b.x = xb_xcc_id(); b.st = st;
    if (threadIdx.x == 0) (void)xb_add(&bar[XB_XCNT(b.x)], 1u);
    return b;
}
__device__ __forceinline__ void xcd_barrier_complete(unsigned* bar, unsigned x, unsigned& nloc, unsigned& nx) {
    const unsigned G = gridDim.x * gridDim.y * gridDim.z;
    unsigned sum, cnt, mine, sp = 0u;
    for (;;) {
        sum = 0u; cnt = 0u; mine = 0u;
#pragma unroll
        for (unsigned j = 0; j < 16; ++j) { const unsigned c = xb_ld(&bar[XB_XCNT(j)]); sum += c; cnt += (c > 0u) ? 1u : 0u; mine = (j == x) ? c : mine; }
        if (sum == G) break;
        __builtin_amdgcn_s_sleep(1);
        if ((++sp & 255u) == 0u) { if (xb_ld(&bar[XB_TMO])) break; if (sp > XB_SPIN_CAP) { atomicAdd(&bar[XB_TMO], 1u); break; } }
    }
    nloc = mine > 0u ? mine : 1u; nx = cnt > 0u ? cnt : 1u;
}
__device__ __forceinline__ void xcd_barrier(const XcdBarrier& b) {
    asm volatile("s_waitcnt vmcnt(0)" ::: "memory");
    __syncthreads();
    if (threadIdx.x == 0) {
        unsigned* bar = b.bar;
        __builtin_amdgcn_s_waitcnt(0);
        unsigned nloc = b.st[0], nx = b.st[1];
        if (nloc == 0u) { xcd_barrier_complete(bar, b.x, nloc, nx); b.st[0] = nloc; b.st[1] = nx; }
        const unsigned old = xb_add(&bar[XB_XSUB(b.x)], 1u);
        const unsigned gen = old / nloc;
        if (old + 1u == (gen + 1u) * nloc) {
            __builtin_amdgcn_fence(__ATOMIC_RELEASE, "agent");
            asm volatile("s_waitcnt vmcnt(0)" ::: "memory");
            const unsigned og = xb_add(&bar[XB_TOP], 1u);
            const unsigned tg = og / nx;
            if (og + 1u == (tg + 1u) * nx) xb_add(&bar[XB_TOPGEN], 1u);
            else XB_SPIN(xb_ld(&bar[XB_TOPGEN]) == tg, bar);
            __builtin_amdgcn_fence(__ATOMIC_ACQUIRE, "agent");
            xb_add(&bar[XB_XGEN(b.x)], 1u);
            asm volatile("s_waitcnt vmcnt(0)" ::: "memory");
        } else {
            XB_SPIN(xb_ld(&bar[XB_XGEN(b.x)]) == gen, bar);
            __builtin_amdgcn_fence(__ATOMIC_ACQUIRE, "agent");
            asm volatile("s_waitcnt vmcnt(0)" ::: "memory");
        }
    }
    __syncthreads();
}

namespace pg8 {
constexpr int BM = 256, BK = 64, HALF = 128, HTB = HALF * BK * 2, STAGE_BYTES = 8 * HTB;
__host__ __device__ __forceinline__ int lds_byte(int r, int c) { const int st = (r >> 4) * 2 + (c >> 5), rr = r & 15, cc = c & 31, ob = rr * 64 + cc * 2; return st * 1024 + (ob ^ (((ob >> 9) & 1) << 5)); }
__host__ __device__ __forceinline__ void stage_rc(int b, int& R, int& C) { const int st = b / 1024, sb = b % 1024, swz = sb ^ (((sb >> 9) & 1) << 5); R = (st >> 1) * 16 + swz / 64; C = (st & 1) * 32 + (swz % 64) / 2; }
__host__ __device__ __forceinline__ int perm32(int rho) { const int n = rho >> 4, i = rho & 15; return 8 * (i >> 2) + 4 * n + (i & 3); }

struct Unit { const char* A; const char* B; int pm, pn, e, aux, idx; };

__device__ __forceinline__ unsigned cvt_pk_bf16(float lo, float hi) { unsigned r; asm volatile("v_cvt_pk_bf16_f32 %0, %1, %2" : "=v"(r) : "v"(lo), "v"(hi)); return r; }

__device__ __forceinline__ void rect_order(int wgid, int nM, int nN, int& pm, int& pn) {
    const int nwg = nM * nN; constexpr int NXCD = 8, WGM = 8;
    { const int q = nwg / NXCD, r = nwg % NXCD, xcd = wgid % NXCD, off = wgid / NXCD; wgid = (xcd < r ? xcd * (q + 1) : r * (q + 1) + (xcd - r) * q) + off; }
    const int nig = WGM * nN, gid = wgid / nig, fm = gid * WGM, gsz = (nM - fm) < WGM ? (nM - fm) : WGM;
    pm = fm + ((wgid % nig) % gsz); pn = (wgid % nig) / gsz;
}

template <bool I8> struct AccSel { typedef f32x4 type; };
template <> struct AccSel<true> { typedef i32x4 type; };
template <class Epi, class Sched, bool ALIGN_EPI, bool I8 = false>
__device__ __forceinline__ void gemm_phase(LAS unsigned char* lds, const int K, const Sched& S, const Epi& E) {
    typedef typename AccSel<I8>::type AccT;
    const int PB = I8 ? K : 2 * K;
    const int tid = threadIdx.x, wid = __builtin_amdgcn_readfirstlane(tid >> 6), lane = tid & 63, wr = wid >> 2, wc = wid & 3, fr = lane & 15, fq = lane >> 4;
    const int nt = PB / 128;
    int RA[2], CA[2]; unsigned voffB[2];
#pragma unroll
    for (int i = 0; i < 2; ++i) { int R, C; stage_rc(tid * 16 + i * 8192, R, C); const int Rb = Epi::PERM ? ((R & ~31) + perm32(R & 31)) : R;
        RA[i] = R; CA[i] = C; voffB[i] = (unsigned)(Rb * PB + C * 2); }
    const size_t kstep = 128;
    const size_t hstep = (size_t)HALF * PB;
    const unsigned ldsw = (unsigned)wid * 1024u;
    const int aoff = lds_byte(wr * 64 + fr, fq * 8), boff = lds_byte(wc * 32 + fr, fq * 8);
#define PG8_SA(b, h) (((b) * 2 + (h)) * HTB)
#define PG8_SB(b, h) ((4 + (b) * 2 + (h)) * HTB)
#define PG8_STAGE_B(bufoff, gbase) do { _Pragma("unroll") for (int _i = 0; _i < 2; ++_i) \
        __builtin_amdgcn_global_load_lds((const unsigned*)((const char*)(gbase) + voffB[_i]), (LAS unsigned*)(lds + (bufoff) + ldsw + _i * 8192), 16, 0, 0); } while (0)
#define PG8_STAGE_A(bufoff, gbase, o0, o1) do { \
        __builtin_amdgcn_global_load_lds((const unsigned*)((const char*)(gbase) + (o0)), (LAS unsigned*)(lds + (bufoff) + ldsw), 16, 0, 0); \
        __builtin_amdgcn_global_load_lds((const unsigned*)((const char*)(gbase) + (o1)), (LAS unsigned*)(lds + (bufoff) + ldsw + 8192), 16, 0, 0); } while (0)
#define PG8_LDA(dst, b, h) do { _Pragma("unroll") for (int m = 0; m < 4; ++m) _Pragma("unroll") for (int k = 0; k < 2; ++k) dst[m][k] = *(const LAS bf16x8*)(lds + PG8_SA(b, h) + aoff + m * 2048 + k * 1024); } while (0)
#define PG8_LDB(dst, b, h) do { _Pragma("unroll") for (int n = 0; n < 2; ++n) _Pragma("unroll") for (int k = 0; k < 2; ++k) dst[n][k] = *(const LAS bf16x8*)(lds + PG8_SB(b, h) + boff + n * 2048 + k * 1024); } while (0)
#define PG8_MMA(ai, bj, At, Bt) do { __builtin_amdgcn_s_setprio(1); _Pragma("unroll") for (int m = 0; m < 4; ++m) _Pragma("unroll") for (int n = 0; n < 2; ++n) _Pragma("unroll") for (int k = 0; k < 2; ++k) \
        { if constexpr (I8) acc[ai][bj][m][n] = __builtin_amdgcn_mfma_i32_16x16x64_i8(__builtin_bit_cast(i32x4, Bt[n][k]), __builtin_bit_cast(i32x4, At[m][k]), acc[ai][bj][m][n], 0, 0, 0); \
          else acc[ai][bj][m][n] = __builtin_amdgcn_mfma_f32_16x16x32_bf16(Bt[n][k], At[m][k], acc[ai][bj][m][n], 0, 0, 0); } __builtin_amdgcn_s_setprio(0); } while (0)
#define PG8_WAIT_V(n) asm volatile("s_waitcnt vmcnt(" #n ")" ::: "memory")
#define PG8_WAIT_L(n) asm volatile("s_waitcnt lgkmcnt(" #n ")" ::: "memory")
#define PG8_BAR __builtin_amdgcn_s_barrier()
#define PG8_SCHED __builtin_amdgcn_sched_barrier(0)
    Unit cur, nxt; int ui = 0;
    if (!S.next(0, cur)) return;
    AccT acc[2][2][4][2];
#pragma unroll
    for (int a = 0; a < 2; ++a)
#pragma unroll
        for (int b = 0; b < 2; ++b)
#pragma unroll
            for (int m = 0; m < 4; ++m)
#pragma unroll
                for (int n = 0; n < 2; ++n) acc[a][b][m][n] = (AccT){0, 0, 0, 0};
    bf16x8 At[4][2], B0[2][2], B1[2][2];
    unsigned c00, c01, c10, c11, n00, n01, n10, n11;
    if constexpr (Sched::GATHER) {
        S.arow4_issue(cur, RA[0], RA[1], 128 + RA[0], 128 + RA[1], c00, c01, c10, c11); S.arow4_finish(cur, RA[0], RA[1], 128 + RA[0], 128 + RA[1], CA[0] * 2u, CA[1] * 2u, c00, c01, c10, c11);
    } else {
        c00 = (unsigned)(RA[0] * PB + CA[0] * 2); c01 = (unsigned)(RA[1] * PB + CA[1] * 2); c10 = c00 + (unsigned)hstep; c11 = c01 + (unsigned)hstep;
    }
    n00 = c00; n01 = c01; n10 = c10; n11 = c11;
    const char* cA = cur.A; const char* cB = cur.B;
    PG8_STAGE_B(PG8_SB(0, 0), cB); PG8_STAGE_B(PG8_SB(0, 1), cB + hstep); PG8_STAGE_A(PG8_SA(0, 0), cA, c00, c01); PG8_STAGE_A(PG8_SA(0, 1), cA, c10, c11);
    if (wr == 1) PG8_BAR;
    PG8_WAIT_V(2); PG8_BAR;
    PG8_STAGE_B(PG8_SB(1, 0), cB + kstep); PG8_STAGE_A(PG8_SA(1, 0), cA + kstep, c00, c01); PG8_STAGE_B(PG8_SB(1, 1), cB + hstep + kstep);
    PG8_WAIT_V(6); PG8_BAR;
    for (;;) {
        const bool has_next = S.next(ui + 1, nxt);
        const char* nA = has_next ? nxt.A : cA; const char* nB = has_next ? nxt.B : cB;
        E.stage(cur, lds + SCLZ_OFF + (ui & 1) * 2048, wid, lane);
        if constexpr (Sched::GATHER) {
            if (has_next) S.arow4_dma(nxt, RA[0], RA[1], 128 + RA[0], 128 + RA[1], lds + GROW_OFF + wid * 256);
        }
        for (int t = 0; t < nt; t += 2) {
            const bool last = (t == nt - 2);
            const char* a1 = cA + (size_t)(t + 1) * kstep;
            const char* a2 = last ? nA : cA + (size_t)(t + 2) * kstep; const char* b2 = last ? nB : cB + (size_t)(t + 2) * kstep;
            const char* a3 = a2 + kstep; const char* b3 = b2 + kstep;
            unsigned s00 = c00, s01 = c01, s10 = c10, s11 = c11;
            if constexpr (Sched::GATHER) {
                if (last && has_next) {
                    const volatile LAS unsigned* gr = (const volatile LAS unsigned*)(lds + GROW_OFF + wid * 256) + lane;
                    n00 = gr[0]; n01 = gr[512]; n10 = gr[1024]; n11 = gr[1536];
                    S.arow4_finish(nxt, RA[0], RA[1], 128 + RA[0], 128 + RA[1], CA[0] * 2u, CA[1] * 2u, n00, n01, n10, n11);
                }
                if (last) { s00 = n00; s01 = n01; s10 = n10; s11 = n11; }
            }
            PG8_LDB(B0, 0, 0); PG8_LDB(B1, 0, 1); PG8_SCHED; PG8_LDA(At, 0, 0); PG8_STAGE_A(PG8_SA(1, 1), a1, c10, c11);
            PG8_WAIT_V(8); PG8_WAIT_L(0); PG8_BAR; PG8_MMA(0, 0, At, B0); PG8_MMA(0, 1, At, B1); PG8_BAR; PG8_SCHED;
            PG8_LDA(At, 0, 1); PG8_STAGE_B(PG8_SB(0, 0), b2); PG8_STAGE_B(PG8_SB(0, 1), b2 + hstep); PG8_STAGE_A(PG8_SA(0, 0), a2, s00, s01);
            PG8_WAIT_V(8); PG8_WAIT_L(0); PG8_BAR; PG8_MMA(1, 0, At, B0); PG8_MMA(1, 1, At, B1); PG8_BAR; PG8_SCHED;
            PG8_LDB(B0, 1, 0); PG8_LDB(B1, 1, 1); PG8_SCHED; PG8_LDA(At, 1, 0); PG8_STAGE_A(PG8_SA(0, 1), a2, s10, s11);
            PG8_WAIT_V(8); PG8_WAIT_L(0); PG8_BAR; PG8_MMA(0, 0, At, B0); PG8_MMA(0, 1, At, B1); PG8_BAR; PG8_SCHED;
            PG8_LDA(At, 1, 1); PG8_STAGE_B(PG8_SB(1, 0), b3); PG8_STAGE_B(PG8_SB(1, 1), b3 + hstep); PG8_STAGE_A(PG8_SA(1, 0), a3, s00, s01);
            PG8_WAIT_V(8); PG8_WAIT_L(0); PG8_BAR; PG8_MMA(1, 0, At, B0); PG8_MMA(1, 1, At, B1); PG8_BAR; PG8_SCHED;
        }
        if constexpr (ALIGN_EPI) { if (wr == 0) PG8_BAR; }
        E(acc, cur, wr, wc, fr, fq, lds + SCLZ_OFF + (ui & 1) * 2048);
        if (!has_next) break;
#pragma unroll
        for (int a = 0; a < 2; ++a)
#pragma unroll
            for (int b = 0; b < 2; ++b)
#pragma unroll
                for (int m = 0; m < 4; ++m)
#pragma unroll
                    for (int n = 0; n < 2; ++n) acc[a][b][m][n] = (AccT){0, 0, 0, 0};
        cur = nxt; cA = nA; cB = nB; ++ui;
        c00 = n00; c01 = n01; c10 = n10; c11 = n11;
        if constexpr (ALIGN_EPI) { if (wr == 1) PG8_BAR; }
    }
    PG8_WAIT_V(0);
    if constexpr (!ALIGN_EPI) { if (wr == 0) PG8_BAR; }
    PG8_BAR;
#undef PG8_SA
#undef PG8_SB
#undef PG8_STAGE_A
#undef PG8_STAGE_B
#undef PG8_LDA
#undef PG8_LDB
#undef PG8_MMA
#undef PG8_WAIT_V
#undef PG8_WAIT_L
#undef PG8_BAR
#undef PG8_SCHED
}
}

struct SchedInproj {
    static constexpr bool GATHER = false;
    const char* H; const char* W; int G, c;
    template <bool UNI = true> __device__ __forceinline__ bool next(int i, pg8::Unit& u) const {
        const int L = i * G + c; if (L >= 2304 + 128) return false;
        int pm, pn;
        if (L < 2304) pg8::rect_order(L, 64, 36, pm, pn);
        else { const int idx = L - 2304, q = idx >> 3; pm = 64 + (idx & 7); pn = q < 4 ? q : q + 8; }
        u.pm = pm; u.pn = pn; u.e = 0; u.aux = 0; u.idx = i;
        u.A = H + (size_t)pm * 256 * D; u.B = W + (size_t)pn * 256 * D; return true;
    }
    __device__ __forceinline__ unsigned arow(const pg8::Unit&, int) const { return 0u; }
};
struct SchedSq {
    static constexpr bool GATHER = false;
    const char* A; const char* W; int G, c;
    __device__ __forceinline__ bool next(int i, pg8::Unit& u) const {
        const int L = i * G + c; if (L >= 256) return false;
        int pm, pn; pg8::rect_order(L, 64, 4, pm, pn);
        u.pm = pm; u.pn = pn; u.e = 0; u.aux = 0; u.idx = i;
        u.A = A + (size_t)pm * 256 * D * 2; u.B = W + (size_t)pn * 256 * D * 2; return true;
    }
    __device__ __forceinline__ unsigned arow(const pg8::Unit&, int) const { return 0u; }
};
template <int NT, bool GATH> struct SchedMoe {
    static constexpr bool GATHER = GATH;
    const char* A; const char* W; const int* list; volatile LAS int* tab; int G, c, pb;
    template <bool UNI = true> __device__ __forceinline__ bool next(int i, pg8::Unit& u) const {
        const int L = i * G + c; const int total = tab[32] * NT; if (L >= total) return false;
        int e = 0;
        if constexpr (UNI) {
            const int lj = (int)(threadIdx.x & 31);
            const unsigned long long bal = __ballot(tab[lj] * NT <= L);
            e = __builtin_popcount((unsigned)bal) - 1;
        } else {
#pragma unroll 1
            for (int j = 1; j < 32; ++j) if (L >= tab[j] * NT) e = j;
        }
        const int tp = tab[e], tiles = tab[e + 1] - tp, local = L - tp * NT;
        const int mt = local % tiles, nt = local / tiles;
        u.pm = mt; u.pn = nt; u.e = e; u.aux = (tp + mt) * 256; u.idx = i;
        u.A = GATH ? A : A + (size_t)u.aux * pb;
        u.B = W + ((size_t)e * (NT * 256) + (size_t)nt * 256) * pb; return true;
    }
    __device__ __forceinline__ unsigned arow(const pg8::Unit& u, int R) const {
        const int pos = u.pm * 256 + R, n = tab[64 + u.e];
        const int tok = pos < n ? list[u.e * TL + pos] : 0;
        return (unsigned)tok * (unsigned)pb;
    }
    __device__ __forceinline__ void arow4_issue(const pg8::Unit& u, int R0, int R1, int R2, int R3, unsigned& o0, unsigned& o1, unsigned& o2, unsigned& o3) const {
        const int n = tab[64 + u.e], p0 = u.pm * 256 + R0, p1 = u.pm * 256 + R1, p2 = u.pm * 256 + R2, p3 = u.pm * 256 + R3;
        const int* lp = list + (size_t)u.e * TL;
        o0 = (unsigned)lp[p0 < n ? p0 : 0]; o1 = (unsigned)lp[p1 < n ? p1 : 0]; o2 = (unsigned)lp[p2 < n ? p2 : 0]; o3 = (unsigned)lp[p3 < n ? p3 : 0];
    }
    __device__ __forceinline__ void arow4_dma(const pg8::Unit& u, int R0, int R1, int R2, int R3, LAS unsigned char* dst) const {
        const int n = tab[64 + u.e], p0 = u.pm * 256 + R0, p1 = u.pm * 256 + R1, p2 = u.pm * 256 + R2, p3 = u.pm * 256 + R3;
        const int* lp = list + (size_t)u.e * TL;
        __builtin_amdgcn_global_load_lds((const unsigned*)(lp + (p0 < n ? p0 : 0)), (LAS unsigned*)dst, 4, 0, 0);
        __builtin_amdgcn_global_load_lds((const unsigned*)(lp + (p1 < n ? p1 : 0)), (LAS unsigned*)(dst + 2048), 4, 0, 0);
        __builtin_amdgcn_global_load_lds((const unsigned*)(lp + (p2 < n ? p2 : 0)), (LAS unsigned*)(dst + 4096), 4, 0, 0);
        __builtin_amdgcn_global_load_lds((const unsigned*)(lp + (p3 < n ? p3 : 0)), (LAS unsigned*)(dst + 6144), 4, 0, 0);
    }
    __device__ __forceinline__ void arow4_finish(const pg8::Unit& u, int R0, int R1, int R2, int R3, unsigned c0, unsigned c1, unsigned& o0, unsigned& o1, unsigned& o2, unsigned& o3) const {
        const int n = tab[64 + u.e], p0 = u.pm * 256 + R0, p1 = u.pm * 256 + R1, p2 = u.pm * 256 + R2, p3 = u.pm * 256 + R3;
        o0 = (p0 < n ? o0 : 0u) * (unsigned)pb + c0; o1 = (p1 < n ? o1 : 0u) * (unsigned)pb + c1; o2 = (p2 < n ? o2 : 0u) * (unsigned)pb + c0; o3 = (p3 < n ? o3 : 0u) * (unsigned)pb + c1;
    }
};

constexpr int UCAP = 12, UC_ROWS = 131072, UC_REC = UC_ROWS + UCAP * 1024;
template <class Base, bool ROWS = true> struct SchedCached {
    static constexpr bool GATHER = Base::GATHER;
    Base base; LAS unsigned char* lds;
    __device__ __forceinline__ void init(int tid) {
        volatile LAS unsigned* rec = (volatile LAS unsigned*)(lds + UC_REC);
        if (tid < UCAP) { pg8::Unit u; const bool ok = base.template next<false>(tid, u);
            const unsigned long long a = (unsigned long long)u.A, b = (unsigned long long)u.B;
            rec[tid * 8 + 0] = ok ? (unsigned)a : 0u; rec[tid * 8 + 1] = ok ? (unsigned)(a >> 32) : 0u; rec[tid * 8 + 2] = ok ? (unsigned)b : 0u; rec[tid * 8 + 3] = ok ? (unsigned)(b >> 32) : 0u;
            rec[tid * 8 + 4] = ok ? ((unsigned)u.pm | ((unsigned)u.pn << 16)) : 0xffffffffu; rec[tid * 8 + 5] = (unsigned)u.e; rec[tid * 8 + 6] = (unsigned)u.aux; rec[tid * 8 + 7] = ok ? 1u : 0u; }
        __syncthreads();
        if constexpr (Base::GATHER && ROWS) {
            volatile LAS int* rows = (volatile LAS int*)(lds + UC_ROWS);
            for (int x = tid; x < UCAP * 256; x += NWAVES * 64) { const int i = x >> 8, r = x & 255;
                if (rec[i * 8 + 7]) { pg8::Unit u; u.pm = (int)(rec[i * 8 + 4] & 0xffffu); u.e = (int)rec[i * 8 + 5]; rows[x] = (int)base.arow(u, r); } }
            __syncthreads();
        }
    }
    __device__ __forceinline__ bool next(int i, pg8::Unit& u) const {
        if (i >= UCAP) { const bool ok = base.next(i, u); u.idx = i; return ok; }
        volatile LAS unsigned* rec = (volatile LAS unsigned*)(lds + UC_REC) + i * 8;
        if (!rec[7]) return false;
        u.A = (const char*)((unsigned long long)rec[0] | ((unsigned long long)rec[1] << 32)); u.B = (const char*)((unsigned long long)rec[2] | ((unsigned long long)rec[3] << 32));
        const unsigned pp = rec[4]; u.pm = (int)(pp & 0xffffu); u.pn = (int)(pp >> 16); u.e = (int)rec[5]; u.aux = (int)rec[6]; u.idx = i; return true;
    }
    __device__ __forceinline__ unsigned arow(const pg8::Unit& u, int R) const {
        if constexpr (Base::GATHER && ROWS) { if (u.idx < UCAP) return (unsigned)((volatile LAS int*)(lds + UC_ROWS))[u.idx * 256 + R]; }
        return base.arow(u, R);
    }
    __device__ __forceinline__ void arow4_issue(const pg8::Unit&, int, int, int, int, unsigned&, unsigned&, unsigned&, unsigned&) const {}
    __device__ __forceinline__ void arow4_dma(const pg8::Unit&, int, int, int, int, LAS unsigned char*) const {}
    __device__ __forceinline__ void arow4_finish(const pg8::Unit& u, int R0, int R1, int R2, int R3, unsigned c0, unsigned c1, unsigned& o0, unsigned& o1, unsigned& o2, unsigned& o3) const {
        o0 = arow(u, R0) + c0; o1 = arow(u, R1) + c1; o2 = arow(u, R2) + c0; o3 = arow(u, R3) + c1;
    }
};

struct EpiInproj {
    static constexpr bool PERM = true, HAS_MID = false;
    bf16* P; const float* hs; const float* ws;
    template <bool ACT> __device__ __forceinline__ void body(const i32x4 (&acc)[2][2][4][2], bf16* rowbase, const float (&rsv)[2][4], const f32x4 (&wv)[2][2], float c1, float c3, bool sig) const {
#pragma unroll
        for (int ai = 0; ai < 2; ++ai)
#pragma unroll
            for (int m = 0; m < 4; ++m) { const float rs = rsv[ai][m]; bf16* rowp = rowbase + (size_t)(ai * 128 + m * 16) * D;
#pragma unroll
                for (int bj = 0; bj < 2; ++bj) { float o[8];
#pragma unroll
                    for (int q = 0; q < 8; ++q) { const float x = (float)acc[ai][bj][m][q >> 2][q & 3] * (rs * wv[bj][q >> 2][q & 3]);
                        if (!ACT) o[q] = x; else { const float z = x * (c1 + c3 * x * x); const float sg = fast_sigmoid(z); o[q] = sig ? sg : x * sg; } }
                    u32x4 w; w.x = pkbf(o[0], o[1]); w.y = pkbf(o[2], o[3]); w.z = pkbf(o[4], o[5]); w.w = pkbf(o[6], o[7]);
                    __builtin_nontemporal_store(w, (u32x4*)(rowp + bj * 128)); } }
    }
    __device__ __forceinline__ void stage(const pg8::Unit& u, LAS unsigned char* z, int wid, int lane) const {
        if (wid == 0) __builtin_amdgcn_global_load_lds((const unsigned*)(hs + u.pm * 256 + 4 * lane), (LAS unsigned*)z, 16, 0, 0);
        if (wid == 1) __builtin_amdgcn_global_load_lds((const unsigned*)(ws + u.pn * 256 + 4 * lane), (LAS unsigned*)(z + 1024), 16, 0, 0);
    }
    __device__ __forceinline__ void operator()(const i32x4 (&acc)[2][2][4][2], const pg8::Unit& u, int wr, int wc, int fr, int fq, const LAS unsigned char* z) const {
        const int pn = __builtin_amdgcn_readfirstlane(u.pn), pm = __builtin_amdgcn_readfirstlane(u.pm);
        const int grp = pn >> 2, colt = (pn & 3) * 256;
        const int row0 = pm * 256 + wr * 64 + fr, col0 = colt + wc * 32 + 8 * fq;
        const int mode = (grp == 1) ? 1 : (grp == 2 || grp == 6) ? 2 : (grp >= 7) ? 3 : 0;
        f32x4 wv[2][2]; float rsv[2][4];
        const LAS float* zr = (const LAS float*)z + wr * 64 + fr; const LAS float* zc = (const LAS float*)(z + 1024) + wc * 32 + 8 * fq;
#pragma unroll
        for (int bj = 0; bj < 2; ++bj)
#pragma unroll
            for (int n = 0; n < 2; ++n) wv[bj][n] = *(const LAS f32x4*)(zc + bj * 128 + 4 * n);
#pragma unroll
        for (int ai = 0; ai < 2; ++ai)
#pragma unroll
            for (int m = 0; m < 4; ++m) rsv[ai][m] = zr[ai * 128 + m * 16];
        bf16* rowbase = P + (size_t)grp * PG_STRIDE + (size_t)row0 * D + col0;
        if (mode == 0) body<false>(acc, rowbase, rsv, wv, 1.f, 0.f, false);
        else body<true>(acc, rowbase, rsv, wv, (mode == 1) ? 1.5957691216f : 1.f, (mode == 1) ? 0.0713548163f : 0.f, mode == 3);
    }
};
template <int MODE> struct EpiMerge {
    static constexpr bool PERM = true;
    bf16* O; const bf16* gate; const bf16* prev;
    __device__ __forceinline__ void stage(const pg8::Unit&, LAS unsigned char*, int, int) const {}
    __device__ __forceinline__ void operator()(const f32x4 (&acc)[2][2][4][2], const pg8::Unit& u, int wr, int wc, int fr, int fq, const LAS unsigned char*) const {
        const int row0 = u.pm * 256 + wr * 64 + fr, col0 = u.pn * 256 + wc * 32 + 8 * fq;
        const size_t off0 = (size_t)row0 * D + col0;
        u32x4 g[2][4][2], p[MODE == 1 ? 2 : 1][4][2], w[2][4][2];
#define EM_LOAD(ai) do { _Pragma("unroll") for (int m = 0; m < 4; ++m) _Pragma("unroll") for (int bj = 0; bj < 2; ++bj) { const size_t off = off0 + (size_t)((ai) * 128 + m * 16) * D + bj * 128; \
            g[ai][m][bj] = *(const u32x4*)(gate + off); if (MODE == 1) p[MODE == 1 ? (ai) : 0][m][bj] = *(const u32x4*)(prev + off); } } while (0)
#define EM_CALC(ai) do { _Pragma("unroll") for (int m = 0; m < 4; ++m) _Pragma("unroll") for (int bj = 0; bj < 2; ++bj) { const u32x4 gg = g[ai][m][bj]; float o[8]; const f32x4 v0 = acc[ai][bj][m][0], v1 = acc[ai][bj][m][1]; \
            o[0] = v0[0] * bflo(gg.x); o[1] = v0[1] * bfhi(gg.x); o[2] = v0[2] * bflo(gg.y); o[3] = v0[3] * bfhi(gg.y); o[4] = v1[0] * bflo(gg.z); o[5] = v1[1] * bfhi(gg.z); o[6] = v1[2] * bflo(gg.w); o[7] = v1[3] * bfhi(gg.w); \
            if (MODE == 1) { const u32x4 pp = p[MODE == 1 ? (ai) : 0][m][bj]; o[0] += bflo(pp.x); o[1] += bfhi(pp.x); o[2] += bflo(pp.y); o[3] += bfhi(pp.y); o[4] += bflo(pp.z); o[5] += bfhi(pp.z); o[6] += bflo(pp.w); o[7] += bfhi(pp.w); } \
            w[ai][m][bj] = (u32x4){pkbf(o[0], o[1]), pkbf(o[2], o[3]), pkbf(o[4], o[5]), pkbf(o[6], o[7])}; } } while (0)
#define EM_STORE(ai) do { _Pragma("unroll") for (int m = 0; m < 4; ++m) _Pragma("unroll") for (int bj = 0; bj < 2; ++bj) *(u32x4*)(O + off0 + (size_t)((ai) * 128 + m * 16) * D + bj * 128) = w[ai][m][bj]; } while (0)
        EM_LOAD(0); __builtin_amdgcn_sched_barrier(0); EM_CALC(0); __builtin_amdgcn_sched_barrier(0);
        EM_LOAD(1); __builtin_amdgcn_sched_barrier(0); EM_STORE(0); __builtin_amdgcn_sched_barrier(0);
        EM_CALC(1); EM_STORE(1);
#undef EM_LOAD
#undef EM_CALC
#undef EM_STORE
    }
};
struct EpiX1 {
    static constexpr bool PERM = true;
    bf16* X1; const float* x; const float* mod;
    __device__ __forceinline__ void stage(const pg8::Unit&, LAS unsigned char*, int, int) const {}
    __device__ __forceinline__ void operator()(const f32x4 (&acc)[2][2][4][2], const pg8::Unit& u, int wr, int wc, int fr, int fq, const LAS unsigned char*) const {
        const int row0 = u.pm * 256 + wr * 64 + fr, col0 = u.pn * 256 + wc * 32 + 8 * fq;
        const float* mg = mod + (size_t)(u.pm >> 3) * NMOD + 2 * D;
        f32x4 gv[2][2];
#pragma unroll
        for (int bj = 0; bj < 2; ++bj)
#pragma unroll
            for (int n = 0; n < 2; ++n) gv[bj][n] = *(const f32x4*)(mg + col0 + bj * 128 + 4 * n);
        const size_t off0 = (size_t)row0 * D + col0;
        f32x4 xv[2][4][2][2];
#define EX_LOAD(ai) do { _Pragma("unroll") for (int m = 0; m < 4; ++m) _Pragma("unroll") for (int bj = 0; bj < 2; ++bj) _Pragma("unroll") for (int n = 0; n < 2; ++n) \
            xv[ai][m][bj][n] = *(const f32x4*)(x + off0 + (size_t)((ai) * 128 + m * 16) * D + bj * 128 + 4 * n); } while (0)
#define EX_CALC(ai) do { _Pragma("unroll") for (int m = 0; m < 4; ++m) _Pragma("unroll") for (int bj = 0; bj < 2; ++bj) _Pragma("unroll") for (int n = 0; n < 2; ++n) \
            xv[ai][m][bj][n] = xv[ai][m][bj][n] + gv[bj][n] * acc[ai][bj][m][n]; } while (0)
#define EX_STORE(ai) do { _Pragma("unroll") for (int m = 0; m < 4; ++m) _Pragma("unroll") for (int bj = 0; bj < 2; ++bj) { const f32x4 v0 = xv[ai][m][bj][0], v1 = xv[ai][m][bj][1]; \
            *(u32x4*)(X1 + off0 + (size_t)((ai) * 128 + m * 16) * D + bj * 128) = (u32x4){pkbf(v0[0], v0[1]), pkbf(v0[2], v0[3]), pkbf(v1[0], v1[1]), pkbf(v1[2], v1[3])}; } } while (0)
        EX_LOAD(0); __builtin_amdgcn_sched_barrier(0); EX_CALC(0); __builtin_amdgcn_sched_barrier(0);
        EX_LOAD(1); __builtin_amdgcn_sched_barrier(0); EX_STORE(0); __builtin_amdgcn_sched_barrier(0);
        EX_CALC(1); EX_STORE(1);
#undef EX_LOAD
#undef EX_CALC
#undef EX_STORE
    }
};
struct EpiAct {
    static constexpr bool PERM = true, HAS_MID = false;
    bf16* ACT; const float* b1; const float* scl; const float* sw1;
    __device__ __forceinline__ void stage(const pg8::Unit& u, LAS unsigned char* z, int wid, int lane) const {
        if (wid == 0) __builtin_amdgcn_global_load_lds((const unsigned*)(scl + (size_t)u.e * TL + u.pm * 256 + 4 * lane), (LAS unsigned*)z, 16, 0, 0);
        if (wid == 1) __builtin_amdgcn_global_load_lds((const unsigned*)(b1 + (size_t)u.e * 2048 + u.pn * 256 + 4 * lane), (LAS unsigned*)(z + 1024), 16, 0, 0);
    }
    __device__ __forceinline__ void operator()(const i32x4 (&acc)[2][2][4][2], const pg8::Unit& u, int wr, int wc, int fr, int fq, const LAS unsigned char* z) const {
        const int row0 = u.aux + wr * 64 + fr;
        const int vc0 = u.pn * 256 + wc * 32 + 8 * fq;
        const float sw = sw1[u.e];
        float rs[2][4]; f32x4 ba[2], bbv[2];
        const LAS float* zr = (const LAS float*)z + wr * 64 + fr; const LAS float* zc = (const LAS float*)(z + 1024) + wc * 32 + 8 * fq;
#pragma unroll
        for (int ai = 0; ai < 2; ++ai)
#pragma unroll
            for (int m = 0; m < 4; ++m) rs[ai][m] = zr[ai * 128 + m * 16];
#pragma unroll
        for (int bj = 0; bj < 2; ++bj) { ba[bj] = *(const LAS f32x4*)(zc + bj * 128); bbv[bj] = *(const LAS f32x4*)(zc + bj * 128 + 4); }
#pragma unroll
        for (int ai = 0; ai < 2; ++ai)
#pragma unroll
            for (int m = 0; m < 4; ++m) rs[ai][m] *= sw;
#pragma unroll
        for (int bj = 0; bj < 2; ++bj) {
            const int vc = vc0 + bj * 128, j0 = vc >> 1;
            const float bg[4] = {ba[bj][0], ba[bj][2], bbv[bj][0], bbv[bj][2]}, bu[4] = {ba[bj][1], ba[bj][3], bbv[bj][1], bbv[bj][3]};
#pragma unroll
            for (int ai = 0; ai < 2; ++ai)
#pragma unroll
                for (int m = 0; m < 4; ++m) { float o[4];
#pragma unroll
                    for (int q = 0; q < 4; ++q) { float hg = (float)acc[ai][bj][m][0][q] * rs[ai][m] + bg[q], hu = (float)acc[ai][bj][m][1][q] * rs[ai][m] + bu[q];
                        hg = fminf(hg, 7.0f); hu = fminf(fmaxf(hu, -7.0f), 7.0f);
                        o[q] = hg * fast_sigmoid(1.702f * hg) * (hu + 1.0f); }
                    u32x2 w; w.x = pkbf(o[0], o[1]); w.y = pkbf(o[2], o[3]);
                    *(u32x2*)(ACT + (size_t)(row0 + ai * 128 + m * 16) * D + j0) = w; }
        }
    }
};
struct EpiY {
    static constexpr bool PERM = true;
    bf16* Y; const float* b2;
    __device__ __forceinline__ void stage(const pg8::Unit& u, LAS unsigned char* z, int wid, int lane) const {
        if (wid == 1) __builtin_amdgcn_global_load_lds((const unsigned*)(b2 + (size_t)u.e * D + u.pn * 256 + 4 * lane), (LAS unsigned*)(z + 1024), 16, 0, 0);
    }
    __device__ __forceinline__ void operator()(const f32x4 (&acc)[2][2][4][2], const pg8::Unit& u, int wr, int wc, int fr, int fq, const LAS unsigned char* z) const {
        const int row0 = u.aux + wr * 64 + fr, col0 = u.pn * 256 + wc * 32 + 8 * fq;
        const LAS float* zc = (const LAS float*)(z + 1024) + wc * 32 + 8 * fq;
        f32x4 bv[2][2];
#pragma unroll
        for (int bj = 0; bj < 2; ++bj)
#pragma unroll
            for (int n = 0; n < 2; ++n) bv[bj][n] = *(const LAS f32x4*)(zc + bj * 128 + 4 * n);
#pragma unroll
        for (int ai = 0; ai < 2; ++ai)
#pragma unroll
            for (int m = 0; m < 4; ++m) { bf16* rowp = Y + (size_t)(row0 + ai * 128 + m * 16) * D + col0;
#pragma unroll
                for (int bj = 0; bj < 2; ++bj) { const f32x4 v0 = acc[ai][bj][m][0] + bv[bj][0], v1 = acc[ai][bj][m][1] + bv[bj][1];
                    u32x4 w; w.x = pkbf(v0[0], v0[1]); w.y = pkbf(v0[2], v0[3]); w.z = pkbf(v1[0], v1[1]); w.w = pkbf(v1[2], v1[3]);
                    *(u32x4*)(rowp + bj * 128) = w; } }
    }
};

struct Args { const float* in[28]; float* out; unsigned char* ws; int ph_lo, ph_hi; };
struct Frame {
    LAS unsigned char* lds; int tid, lane, wave, G, vcu; unsigned char* ws; const float* const* in; float* out;
};
enum { I_X = 0, I_C, I_CTX, I_CCTX, I_ADAW, I_ADAB, I_N1G, I_N2G, I_WIN, I_CONVW, I_CONVB, I_WA, I_BA, I_WX, I_BX, I_LAM, I_LBL, I_HGG, I_WBA, I_WBB, I_WOUT,
       I_RW, I_RB, I_W1, I_B1, I_W2, I_B2, I_FG };

__device__ __forceinline__ void transpose_item(const float* W, int K, int N, bf16* WT, int row_off, LAS float* scr, int item, int lane, bool swz) {
    const int nblk = N / 32, kb = item / nblk, nb = item % nblk, k0 = 64 * kb, n0 = 32 * nb;
    float tv[32];
#pragma unroll
    for (int i = 0; i < 32; ++i) { const int kk = 2 * i + (lane >> 5); tv[i] = W[(size_t)(k0 + kk) * N + n0 + (lane & 31)]; }
#pragma unroll
    for (int i = 0; i < 32; ++i) { const int kk = 2 * i + (lane >> 5); scr[kk * 33 + (lane & 31)] = tv[i]; }
    LDS_WAIT(); asm volatile("" ::: "memory");
    const int c = lane & 7;
#pragma unroll
    for (int j = 0; j < 4; ++j) { const int n = (lane >> 3) + 8 * j; const LAS float* s = scr + (8 * c) * 33 + n;
        u32x4 o; o.x = pk2(s[0 * 33], s[1 * 33]); o.y = pk2(s[2 * 33], s[3 * 33]); o.z = pk2(s[4 * 33], s[5 * 33]); o.w = pk2(s[6 * 33], s[7 * 33]);
        const int x = n & 7, nv = swz ? ((n & ~7) + ((x & 1) * 4 + (x >> 1))) : n;
        *(u32x4*)(WT + (size_t)(row_off + n0 + nv) * K + k0 + 8 * c) = o; }
    LDS_WAIT(); asm volatile("" ::: "memory");
}
constexpr int MOE_ITEMS = 32 * 32 * 64 + 32 * 32 * 32;
struct MoeItem { const float* W; bf16* WT; int N, k0, n0; bool swz; float inv; };
template <bool LOAD_INV = true> __device__ __forceinline__ MoeItem moe_item(const Frame& F, int item) {
    MoeItem m;
    if (item < 65536) { const int e = item >> 11, sub = item & 2047, kb = sub >> 6, nb = sub & 63;
        m.W = F.in[I_W1] + (size_t)e * D * 2048; m.WT = (bf16*)(F.ws + WS_W1 + (size_t)e * 2048 * D); m.N = 2048; m.k0 = kb * 32; m.n0 = nb * 32; m.swz = true; m.inv = LOAD_INV ? ((const float*)(F.ws + WS_SW1))[32 + e] : 1.0f; }
    else { const int r = item - 65536, e = r >> 10, sub = r & 1023, kb = sub >> 5, nb = sub & 31;
        m.W = F.in[I_W2] + (size_t)e * D * D; m.WT = (bf16*)(F.ws + WS_W2) + (size_t)e * D * D; m.N = D; m.k0 = kb * 32; m.n0 = nb * 32; m.swz = false; m.inv = 1.0f; }
    return m;
}
__device__ __forceinline__ void moe_conv_issue(const MoeItem& m, int lane, float (&tv)[16]) {
#pragma unroll
    for (int i = 0; i < 16; ++i) tv[i] = m.W[(size_t)(m.k0 + 2 * i + (lane >> 5)) * m.N + m.n0 + (lane & 31)];
}
__device__ __forceinline__ void moe_conv_finish(const MoeItem& m, int lane, const float (&tv)[16], LAS float* scr) {
#pragma unroll
    for (int i = 0; i < 16; ++i) scr[(2 * i + (lane >> 5)) * 33 + (lane & 31)] = tv[i];
    asm volatile("" ::: "memory");
    const int n = lane >> 1, hk = (lane & 1) * 16;
    const int x = n & 7, nv = m.swz ? ((n & ~7) + ((x & 1) * 4 + (x >> 1))) : n;
    if (m.swz) {
        unsigned o[4];
#pragma unroll
        for (int j = 0; j < 4; ++j) { unsigned wv = 0u;
#pragma unroll
            for (int b = 0; b < 4; ++b) { int q = (int)rintf(scr[(hk + 4 * j + b) * 33 + n] * m.inv); q = q > 127 ? 127 : (q < -127 ? -127 : q); wv |= (unsigned)(q & 255) << (8 * b); }
            o[j] = wv; }
        unsigned char* dst = (unsigned char*)m.WT + (size_t)(m.n0 + nv) * D + m.k0 + hk;
        *(u32x4*)dst = (u32x4){o[0], o[1], o[2], o[3]};
    } else {
        unsigned o[8];
#pragma unroll
        for (int j = 0; j < 8; ++j) o[j] = pkbf(scr[(hk + 2 * j) * 33 + n], scr[(hk + 2 * j + 1) * 33 + n]);
        bf16* dst = m.WT + (size_t)(m.n0 + nv) * D + m.k0 + hk;
        *(u32x4*)dst = (u32x4){o[0], o[1], o[2], o[3]}; *(u32x4*)(dst + 8) = (u32x4){o[4], o[5], o[6], o[7]};
    }
    asm volatile("" ::: "memory");
}
__device__ __forceinline__ void moe_dma_issue(const MoeItem& m, int lane, LAS unsigned char* scr) {
#pragma unroll
    for (int j = 0; j < 4; ++j) { const int q = j * 64 + lane, r = q >> 3, c = (q & 7) ^ (r & 7);
        __builtin_amdgcn_global_load_lds((const unsigned*)(m.W + (size_t)(m.k0 + r) * m.N + m.n0 + 4 * c), (LAS unsigned*)(scr + j * 1024), 16, 0, 0); }
}
__device__ __forceinline__ void moe_dma_finish(const MoeItem& m, int lane, const LAS unsigned char* scr) {
    const int n = lane >> 1, hk = (lane & 1) * 16;
    const int x = n & 7, nv = m.swz ? ((n & ~7) + ((x & 1) * 4 + (x >> 1))) : n;
    float v[16];
#pragma unroll
    for (int i = 0; i < 16; ++i) { const int r = hk + i; v[i] = *(const LAS float*)(scr + r * 128 + (((n >> 2) ^ (r & 7)) * 16) + (n & 3) * 4); }
    if (m.swz) {
        unsigned o[4];
#pragma unroll
        for (int j = 0; j < 4; ++j) { unsigned wv = 0u;
#pragma unroll
            for (int b = 0; b < 4; ++b) { int q = (int)rintf(v[4 * j + b] * m.inv); q = q > 127 ? 127 : (q < -127 ? -127 : q); wv |= (unsigned)(q & 255) << (8 * b); }
            o[j] = wv; }
        unsigned char* dst = (unsigned char*)m.WT + (size_t)(m.n0 + nv) * D + m.k0 + hk;
        *(u32x4*)dst = (u32x4){o[0], o[1], o[2], o[3]};
    } else {
        unsigned o[8];
#pragma unroll
        for (int j = 0; j < 8; ++j) o[j] = pkbf(v[2 * j], v[2 * j + 1]);
        bf16* dst = m.WT + (size_t)(m.n0 + nv) * D + m.k0 + hk;
        *(u32x4*)dst = (u32x4){o[0], o[1], o[2], o[3]}; *(u32x4*)(dst + 8) = (u32x4){o[4], o[5], o[6], o[7]};
    }
}
__device__ __forceinline__ void p0_prologue(const Frame& F) {
    {
        LAS float* sc = (LAS float*)F.lds;
        LAS float* red = (LAS float*)(F.lds + 40960);
        bool loaded = false;
        for (int item = blockIdx.x; item < NMOD / 32; item += F.G) {
            if (!loaded) {
                for (int i = F.tid; i < 9 * D; i += 512) { const int v = i >> 10, k = i & 1023; const float cvv = v < 8 ? F.in[I_C][v * D + k] : F.in[I_CCTX][k];
                    sc[i] = cvv / (1.0f + __expf(-cvv)); }
                loaded = true; __syncthreads();
            }
            const int col = F.tid & 31, kg = F.tid >> 5, n0 = item * 32;
            float a[9];
#pragma unroll
            for (int v = 0; v < 9; ++v) a[v] = 0.f;
            const float* wp = F.in[I_ADAW] + n0 + col;
            float wv[64];
#pragma unroll
            for (int kk = 0; kk < 64; ++kk) wv[kk] = wp[(size_t)(kg + 16 * kk) * NMOD];
#pragma unroll
            for (int kk = 0; kk < 64; ++kk) { const int k = kg + 16 * kk; const float w = wv[kk];
#pragma unroll
                for (int v = 0; v < 9; ++v) a[v] += sc[v * D + k] * w; }
#pragma unroll
            for (int v = 0; v < 9; ++v) red[(kg * 9 + v) * 32 + col] = a[v];
            __syncthreads();
            if (F.tid < 288) { const int v = F.tid >> 5, cc = F.tid & 31; float s = 0.f;
#pragma unroll
                for (int g = 0; g < 16; ++g) s += red[(g * 9 + v) * 32 + cc];
                ((float*)(F.ws + WS_MOD))[(size_t)v * NMOD + n0 + cc] = s + F.in[I_ADAB][n0 + cc]; }
            __syncthreads();
        }
        __syncthreads();
    }
    if (blockIdx.x == F.G - 1) { for (int i = F.tid; i < 2 * D; i += 512) { const float nl = -F.in[I_LAM][i]; ((float*)(F.ws + WS_SPL))[i] = 1.44269504089f * 8.0f * (fmaxf(nl, 0.f) + log1pf(expf(-fabsf(nl)))); } }
    if (blockIdx.x < 32) {
        LAS float* RD = (LAS float*)(F.lds + 65536);
        const float* W = F.in[I_W1] + (size_t)blockIdx.x * D * 2048;
        float mx = 0.f;
#pragma unroll 8
        for (int i = 0; i < 64; ++i) { const f32x4 v = *(const f32x4*)(W + (size_t)i * 2048 + 4 * F.tid); mx = fmaxf(mx, fmaxf(fmaxf(fabsf(v[0]), fabsf(v[1])), fmaxf(fabsf(v[2]), fabsf(v[3])))); }
#pragma unroll
        for (int o = 1; o < 64; o <<= 1) mx = fmaxf(mx, __shfl_xor(mx, o));
        if (F.lane == 0) RD[F.wave] = mx;
        __syncthreads();
        if (F.tid == 0) { float m8 = 0.f; for (int w8 = 0; w8 < 8; ++w8) m8 = fmaxf(m8, RD[w8]); const float sc = m8 > 0.f ? 1.3f * m8 * (1.0f / 127.0f) : 1.0f; ((float*)(F.ws + WS_SW1))[blockIdx.x] = sc; ((float*)(F.ws + WS_SW1))[32 + blockIdx.x] = 1.0f / sc; }
        __syncthreads();
    }
    {
        LAS float* CM = (LAS float*)(F.lds + 65536);
        LAS unsigned char* T8 = F.lds + 66560 + F.wave * 4224;
        const float* W = F.in[I_WIN]; unsigned char* WT = F.ws + WS_WIN; float* WSC = (float*)(F.ws + WS_WINS);
        for (int slab = blockIdx.x; slab < 288; slab += F.G) {
            const int n0 = slab * 32, col = F.lane & 31, hi = F.lane >> 5, k0 = 128 * F.wave;
            float tv[64]; float mx = 0.f;
#pragma unroll
            for (int i = 0; i < 64; ++i) { tv[i] = W[(size_t)(k0 + 2 * i + hi) * (9 * D) + n0 + col]; }
#pragma unroll
            for (int i = 0; i < 64; ++i) mx = fmaxf(mx, fabsf(tv[i]));
            mx = fmaxf(mx, __shfl_xor(mx, 32));
            if (hi == 0) CM[F.wave * 32 + col] = mx;
            __syncthreads();
            float cmx = 0.f;
#pragma unroll
            for (int w8 = 0; w8 < 8; ++w8) cmx = fmaxf(cmx, CM[w8 * 32 + col]);
            const float sc = cmx > 0.f ? cmx * (1.0f / 127.0f) : 1.0f, inv = 1.0f / sc;
            if (F.wave == 0 && hi == 0) WSC[n0 + col] = sc;
#pragma unroll
            for (int i = 0; i < 64; ++i) T8[col * 132 + 2 * i + hi] = (unsigned char)((int)rintf(tv[i] * inv) & 255);
            LDS_WAIT(); asm volatile("" ::: "memory");
#pragma unroll
            for (int j = 0; j < 4; ++j) { const int ch = F.lane + 64 * j, n = ch >> 3, c16 = ch & 7;
                const LAS unsigned* sp = (const LAS unsigned*)(T8 + n * 132 + c16 * 16);
                *(u32x4*)(WT + (size_t)(n0 + n) * D + k0 + c16 * 16) = (u32x4){sp[0], sp[1], sp[2], sp[3]}; }
            __syncthreads();
        }
    }
    LAS float* scr = (LAS float*)(F.lds + F.wave * 16384);
    const int gw = F.vcu * NWAVES + F.wave, NGW = F.G * NWAVES;
    constexpr int I_SQ = 16 * 32, I_LRU = 32 * 8;
    constexpr int NITEMS = 3 * I_SQ + I_LRU;
    for (int it = gw; it < NITEMS; it += NGW) {
        int r = it;
        if (r < I_SQ) { transpose_item(F.in[I_WBA], D, D, (bf16*)(F.ws + WS_WBA), 0, scr, r, F.lane, false); continue; } r -= I_SQ;
        if (r < I_SQ) { transpose_item(F.in[I_WBB], D, D, (bf16*)(F.ws + WS_WBB), 0, scr, r, F.lane, false); continue; } r -= I_SQ;
        if (r < I_SQ) { transpose_item(F.in[I_WOUT], D, D, (bf16*)(F.ws + WS_WOUT), 0, scr, r, F.lane, false); continue; } r -= I_SQ;
        { const int mat = r >> 3, sub = r & 7, z = mat >> 4, dg = mat & 15, d = dg >> 3, g = dg & 7;
            transpose_item(F.in[z ? I_WX : I_WA] + (size_t)dg * 16384, 128, 128, (bf16*)(F.ws + WS_LRUW) + (size_t)((d * 2 + z) * 8 + g) * 16384, 0, scr, sub, F.lane, false); }
    }
}

__device__ __forceinline__ void p1_norm(const Frame& F) {
    const int gw = F.vcu * NWAVES + F.wave, NGW = F.G * NWAVES;
    const float* g1 = F.in[I_N1G]; const float* mod = (const float*)(F.ws + WS_MOD);
    unsigned char* H = F.ws + WS_H; float* HS = (float*)(F.ws + WS_HS);
    for (int r = gw; r < TT; r += NGW) {
        const float* src = r < TL ? F.in[I_X] + (size_t)r * D : F.in[I_CTX] + (size_t)(r - TL) * D;
        const float* mv = mod + (size_t)(r < TL ? (r >> 11) : 8) * NMOD;
        f32x4 v[4]; float ss = 0.f;
#pragma unroll
        for (int j = 0; j < 4; ++j) { v[j] = *(const f32x4*)(src + 4 * F.lane + 256 * j); ss += (v[j][0] * v[j][0] + v[j][1] * v[j][1]) + (v[j][2] * v[j][2] + v[j][3] * v[j][3]); }
        const float rstd = 1.0f / sqrtf(wave_sum(ss) * (1.0f / D) + EPS);
        float amax = 0.f;
#pragma unroll
        for (int j = 0; j < 4; ++j) { const int c = 4 * F.lane + 256 * j;
            const f32x4 g = *(const f32x4*)(g1 + c), sh = *(const f32x4*)(mv + c), scl = *(const f32x4*)(mv + D + c);
            v[j] = v[j] * rstd * g * (scl + 1.0f) + sh;
            amax = fmaxf(amax, fmaxf(fmaxf(fabsf(v[j][0]), fabsf(v[j][1])), fmaxf(fabsf(v[j][2]), fabsf(v[j][3])))); }
#pragma unroll
        for (int o = 1; o < 64; o <<= 1) amax = fmaxf(amax, __shfl_xor(amax, o));
        const float sc = amax > 0.f ? amax * (1.0f / 127.0f) : 1.0f, inv = 1.0f / sc;
#pragma unroll
        for (int j = 0; j < 4; ++j) { const int c = 4 * F.lane + 256 * j;
            const int q0 = (int)rintf(v[j][0] * inv), q1 = (int)rintf(v[j][1] * inv), q2 = (int)rintf(v[j][2] * inv), q3 = (int)rintf(v[j][3] * inv);
            *(unsigned*)(H + (size_t)r * D + c) = (unsigned)(q0 & 255) | ((unsigned)(q1 & 255) << 8) | ((unsigned)(q2 & 255) << 16) | ((unsigned)(q3 & 255) << 24); }
        if (F.lane == 0) HS[r] = sc;
    }
}

constexpr int LRU_U_OFF = 131072, LRU_U_STRIDE = 272;
template <int PASS> __device__ __forceinline__ void lru_phase(const Frame& F, int widx, int nw) {
    const bf16* PAX = (const bf16*)(F.ws + WS_P);
    const bf16* PAG = (const bf16*)(F.ws + WS_P) + PG_STRIDE;
    const bf16* LW = (const bf16*)(F.ws + WS_LRUW);
    float* AGG = (float*)(F.ws + WS_AGG);
    bf16* A1 = (bf16*)(F.ws + WS_A1);
    LAS float* AF = (LAS float*)F.lds;
    LAS unsigned char* UL = F.lds + LRU_U_OFF;
    const int fr = F.lane & 15, fq = F.lane >> 4, w = F.wave;
    const int c8 = (F.tid & 15) * 8, pr = F.tid >> 4;
    for (int vw = widx; vw < 256; vw += nw) {
        const int g = vw & 7, b = (vw >> 3) & 7, q = vw >> 6;
        const int jt0 = PASS == 1 ? 9 * q : 4 + 8 * q, ntile = PASS == 1 ? 9 : 8;
        float cin[8];
#pragma unroll
        for (int i = 0; i < 8; ++i) cin[i] = 0.f;
        if (PASS == 2 && F.wave < 4) {
            const int d = F.wave >> 1, gc = g * 128 + (F.tid & 127);
            const float* aggA = AGG + ((size_t)(0 * 2 + d) * NB + b) * 36 * D; const float* aggH = AGG + ((size_t)(1 * 2 + d) * NB + b) * 36 * D;
            float ca[36], chh[36];
            if (d == 0) {
#pragma unroll
                for (int k = 0; k < 36; ++k) { ca[k] = aggA[(size_t)k * D + gc]; chh[k] = aggH[(size_t)k * D + gc]; }
            } else {
#pragma unroll
                for (int k = 0; k < 36; ++k) { const int sq = k < 4 ? 3 - k : 39 - k; ca[k] = aggA[(size_t)sq * D + gc]; chh[k] = aggH[(size_t)sq * D + gc]; }
            }
            float h = 0.f;
#pragma unroll
            for (int k = 0; k < 36; ++k) { const int sq = d ? (k < 4 ? 3 - k : 39 - k) : k;
#pragma unroll
                for (int i = 0; i < 8; ++i) cin[i] = (sq == jt0 + i) ? h : cin[i];
                h = ca[k] * h + chh[k]; }
        }
        bf16x8 fa[2][4], fx[2][4]; f32x4 bav[2], bxv[2], splv[2];
        const int ch0 = g * 128 + 16 * w + 4 * fq;
#pragma unroll
        for (int d = 0; d < 2; ++d) {
            const bf16* wa = LW + (size_t)((d * 2 + 0) * 8 + g) * 16384 + (size_t)(16 * w + fr) * 128 + fq * 8;
            const bf16* wx = LW + (size_t)((d * 2 + 1) * 8 + g) * 16384 + (size_t)(16 * w + fr) * 128 + fq * 8;
            if (PASS == 1) {
#pragma unroll
            for (int kk = 0; kk < 4; ++kk) { fa[d][kk] = *(const bf16x8*)(wa + kk * 32); fx[d][kk] = *(const bf16x8*)(wx + kk * 32); } }
            bav[d] = *(const f32x4*)(F.in[I_BA] + d * D + ch0) * -1.44269504089f; bxv[d] = *(const f32x4*)(F.in[I_BX] + d * D + ch0) * -1.44269504089f; splv[d] = *(const f32x4*)((const float*)(F.ws + WS_SPL) + d * D + ch0);
        }
#pragma unroll 1
        for (int ti = 0; ti < ntile; ++ti) {
            const int jt = jt0 + ti;
            const bool isctx = jt < 4;
            const int row0 = isctx ? TL + b * CTXL + jt * 64 : b * SEQ + (jt - 4) * 64;
            const int plo = isctx ? -jt * 64 : 0, phi = isctx ? CTXL - 1 - jt * 64 : 63;
            {
                const float* cw = F.in[I_CONVW] + g * 128 + c8; const float* cb = F.in[I_CONVB] + g * 128 + c8;
                u32x4 xv[2][4]; float msk[2][4];
#pragma unroll
                for (int hh = 0; hh < 2; ++hh)
#pragma unroll
                    for (int k = 0; k < 4; ++k) { const int pp = pr + 32 * hh + k - 2; const bool valid = pp >= plo && pp <= phi; const int pc = valid ? pp : 0;
                        msk[hh][k] = valid ? 1.0f : 0.0f; xv[hh][k] = *(const u32x4*)(PAX + (size_t)(row0 + pc) * D + g * 128 + c8); }
                f32x4 w0[4], w1[4];
#pragma unroll
                for (int k = 0; k < 4; ++k) { w0[k] = *(const f32x4*)(cw + k * D); w1[k] = *(const f32x4*)(cw + k * D + 4); }
                const f32x4 b0 = *(const f32x4*)cb, b1 = *(const f32x4*)(cb + 4);
#pragma unroll
                for (int hh = 0; hh < 2; ++hh) { f32x4 o0 = b0, o1 = b1;
#pragma unroll
                    for (int k = 0; k < 4; ++k) { const u32x4 x = xv[hh][k]; const float m = msk[hh][k];
                        o0 += (w0[k] * m) * (f32x4){bflo(x.x), bfhi(x.x), bflo(x.y), bfhi(x.y)}; o1 += (w1[k] * m) * (f32x4){bflo(x.z), bfhi(x.z), bflo(x.w), bfhi(x.w)}; }
                    u32x4 wv; wv.x = pkbf(o0[0], o0[1]); wv.y = pkbf(o0[2], o0[3]); wv.z = pkbf(o1[0], o1[1]); wv.w = pkbf(o1[2], o1[3]);
                    *(LAS u32x4*)(UL + (pr + 32 * hh) * LRU_U_STRIDE + c8 * 2) = wv; }
            }
            u32x4 gg[2];
            if (PASS == 2) {
#pragma unroll
                for (int hh = 0; hh < 2; ++hh) gg[hh] = *(const u32x4*)(PAG + (size_t)(row0 + pr + 32 * hh) * D + g * 128 + c8);
            }
            __syncthreads();
            {
#pragma unroll
                for (int d = 0; d < 2; ++d) {
                    if (PASS == 2) {
                        const bf16* wa = LW + (size_t)((d * 2 + 0) * 8 + g) * 16384 + (size_t)(16 * w + fr) * 128 + fq * 8;
                        const bf16* wx = LW + (size_t)((d * 2 + 1) * 8 + g) * 16384 + (size_t)(16 * w + fr) * 128 + fq * 8;
#pragma unroll
                        for (int kk = 0; kk < 4; ++kk) { fa[d][kk] = *(const bf16x8*)(wa + kk * 32); fx[d][kk] = *(const bf16x8*)(wx + kk * 32); } }
                    LAS float* Ad = AF + (size_t)(2 * d) * 8192; LAS float* Bd = AF + (size_t)(2 * d + 1) * 8192;
#pragma unroll
                    for (int tt = 0; tt < 4; ++tt) { const int t = 16 * tt + fr;
                        bf16x8 ub[4]; f32x4 ga_ = (f32x4){0.f, 0.f, 0.f, 0.f}, gx_ = (f32x4){0.f, 0.f, 0.f, 0.f};
#pragma unroll
                        for (int kk = 0; kk < 4; ++kk) ub[kk] = *(const LAS bf16x8*)(UL + (16 * tt + fr) * LRU_U_STRIDE + kk * 64 + fq * 16);
#pragma unroll
                        for (int kk = 0; kk < 4; ++kk) { ga_ = __builtin_amdgcn_mfma_f32_16x16x32_bf16(fa[d][kk], ub[kk], ga_, 0, 0, 0); gx_ = __builtin_amdgcn_mfma_f32_16x16x32_bf16(fx[d][kk], ub[kk], gx_, 0, 0, 0); }
                        f32x4 ga[4], gx[4]; ga[tt] = ga_; gx[tt] = gx_;
                        const u32x2 uu = *(const LAS u32x2*)(UL + t * LRU_U_STRIDE + (16 * w + 4 * fq) * 2);
                        const float uf[4] = {bflo(uu.x), bfhi(uu.x), bflo(uu.y), bfhi(uu.y)};
                        f32x4 av, bv;
#pragma unroll
                        for (int r = 0; r < 4; ++r) {
                            const float rg = __builtin_amdgcn_rcpf(1.0f + __builtin_amdgcn_exp2f(__builtin_fmaf(ga[tt][r], -1.44269504089f, bav[d][r])));
                            const float ig = __builtin_amdgcn_rcpf(1.0f + __builtin_amdgcn_exp2f(__builtin_fmaf(gx[tt][r], -1.44269504089f, bxv[d][r])));
                            const float t2 = -rg * splv[d][r];
                            const float a = __builtin_amdgcn_exp2f(t2); const float x2 = t2 * 1.38629436112f;
                            const float omx = -x2 * (1.0f + x2 * (0.5f + x2 * (0.16666667f + x2 * (0.041666668f + x2 * (0.0083333338f + x2 * 0.0013888889f)))));
                            av[r] = (PASS == 1) ? t2 : a; bv[r] = __builtin_amdgcn_sqrtf(omx) * ig * uf[r]; }
                        *(LAS f32x4*)(Ad + t * 128 + 16 * w + 4 * fq) = av; *(LAS f32x4*)(Bd + t * 128 + 16 * w + 4 * fq) = bv; }
                }
            }
            __syncthreads();
            if (F.wave < 4) {
                const int d = F.wave >> 1, ch = F.tid & 127, gc = g * 128 + ch;
                LAS float* Ad = AF + (size_t)(2 * d) * 8192 + ch; LAS float* Bd = AF + (size_t)(2 * d + 1) * 8192 + ch;
                if (PASS == 1) {
                    float h = 0.f, ap = 1.f;
#pragma unroll 8
                    for (int s = 0; s < 64; ++s) { const int t = d ? 63 - s : s; const float a = __builtin_amdgcn_exp2f(Ad[t * 128]), bb = Bd[t * 128]; h = a * h + bb; ap *= a; }
                    AGG[(((size_t)(0 * 2 + d) * NB + b) * 36 + jt) * D + gc] = ap; AGG[(((size_t)(1 * 2 + d) * NB + b) * 36 + jt) * D + gc] = h;
                } else {
                    float h = cin[0];
#pragma unroll
                    for (int i = 1; i < 8; ++i) h = (ti == i) ? cin[i] : h;
#pragma unroll 8
                    for (int s = 0; s < 64; ++s) { const int t = d ? 63 - s : s; const float a = Ad[t * 128], bb = Bd[t * 128]; h = a * h + bb; Bd[t * 128] = h; }
                }
            }
            if (PASS == 1 && !isctx) {
                constexpr unsigned dofs[4] = {(unsigned)WS_T1, (unsigned)WS_MM, (unsigned)WS_H2, (unsigned)WS_A2};
#pragma unroll
                for (int hh = 0; hh < 2; ++hh) { const int p = pr + 32 * hh; const unsigned voff = (unsigned)(((row0 + p) * D + g * 128 + c8) * 2);
#pragma unroll
                    for (int k4 = 0; k4 < 4; ++k4) { const LAS float* sp = AF + (size_t)k4 * 8192 + p * 128 + c8;
                        const f32x4 x0 = *(const LAS f32x4*)sp, x1 = *(const LAS f32x4*)(sp + 4);
                        *(u32x4*)(F.ws + (size_t)(dofs[k4] + voff)) = (u32x4){pkbf(x0[0], x0[1]), pkbf(x0[2], x0[3]), pkbf(x1[0], x1[1]), pkbf(x1[2], x1[3])}; } }
            }
            __syncthreads();
            if (PASS == 2) {
#pragma unroll
                for (int hh = 0; hh < 2; ++hh) { const int p = pr + 32 * hh;
                    const LAS float* h0 = AF + 8192 + p * 128 + c8; const LAS float* h1 = AF + 3 * 8192 + p * 128 + c8;
                    const f32x4 x0 = *(const LAS f32x4*)h0, x1 = *(const LAS f32x4*)(h0 + 4), y0 = *(const LAS f32x4*)h1, y1 = *(const LAS f32x4*)(h1 + 4);
                    const u32x4 gv = gg[hh];
                    u32x4 o; o.x = pkbf((x0[0] + y0[0]) * bflo(gv.x), (x0[1] + y0[1]) * bfhi(gv.x)); o.y = pkbf((x0[2] + y0[2]) * bflo(gv.y), (x0[3] + y0[3]) * bfhi(gv.y));
                    o.z = pkbf((x1[0] + y1[0]) * bflo(gv.z), (x1[1] + y1[1]) * bfhi(gv.z)); o.w = pkbf((x1[2] + y1[2]) * bflo(gv.w), (x1[3] + y1[3]) * bfhi(gv.w));
                    *(u32x4*)(A1 + (size_t)(row0 + p) * D + g * 128 + c8) = o; }
                __syncthreads();
            }
        }
    }
}

__device__ __forceinline__ void lru_pass2_stream(const Frame& F, int widx, int nw) {
    const bf16* PAG = (const bf16*)(F.ws + WS_P) + PG_STRIDE;
    const bf16* const src[4] = {(const bf16*)(F.ws + WS_T1), (const bf16*)(F.ws + WS_MM), (const bf16*)(F.ws + WS_H2), (const bf16*)(F.ws + WS_A2)};
    const float* AGG = (const float*)(F.ws + WS_AGG);
    bf16* A1 = (bf16*)(F.ws + WS_A1);
    LAS float* AF = (LAS float*)F.lds;
    const int c8 = (F.tid & 15) * 8, pr = F.tid >> 4;
    for (int vw = widx; vw < 256; vw += nw) {
        const int g = vw & 7, b = (vw >> 3) & 7, q = vw >> 6, jt0 = 4 + 8 * q;
        float cin[8];
#pragma unroll
        for (int i = 0; i < 8; ++i) cin[i] = 0.f;
        if (F.wave < 4) {
            const int d = F.wave >> 1, gc = g * 128 + (F.tid & 127);
            const float* aggA = AGG + ((size_t)(0 * 2 + d) * NB + b) * 36 * D; const float* aggH = AGG + ((size_t)(1 * 2 + d) * NB + b) * 36 * D;
            float ca[36], chh[36];
            if (d == 0) {
#pragma unroll
                for (int k = 0; k < 36; ++k) { ca[k] = aggA[(size_t)k * D + gc]; chh[k] = aggH[(size_t)k * D + gc]; }
            } else {
#pragma unroll
                for (int k = 0; k < 36; ++k) { const int sq = k < 4 ? 3 - k : 39 - k; ca[k] = aggA[(size_t)sq * D + gc]; chh[k] = aggH[(size_t)sq * D + gc]; }
            }
            float h = 0.f;
#pragma unroll
            for (int k = 0; k < 36; ++k) { const int sq = d ? (k < 4 ? 3 - k : 39 - k) : k;
#pragma unroll
                for (int i = 0; i < 8; ++i) cin[i] = (sq == jt0 + i) ? h : cin[i];
                h = ca[k] * h + chh[k]; }
        }
        u32x4 cur[4][2], gg[2];
#define L2_LOAD(TI, DST, GG) do { const int row_ = b * SEQ + (jt0 + (TI) - 4) * 64; \
        _Pragma("unroll") for (int k4 = 0; k4 < 4; ++k4) _Pragma("unroll") for (int hh = 0; hh < 2; ++hh) DST[k4][hh] = *(const u32x4*)(src[k4] + (size_t)(row_ + pr + 32 * hh) * D + g * 128 + c8); \
        _Pragma("unroll") for (int hh = 0; hh < 2; ++hh) GG[hh] = *(const u32x4*)(PAG + (size_t)(row_ + pr + 32 * hh) * D + g * 128 + c8); } while (0)
        L2_LOAD(0, cur, gg);
#pragma unroll 1
        for (int ti = 0; ti < 8; ++ti) {
            const int row0 = b * SEQ + (jt0 + ti - 4) * 64;
#pragma unroll
            for (int k4 = 0; k4 < 4; ++k4)
#pragma unroll
                for (int hh = 0; hh < 2; ++hh) { const u32x4 v = cur[k4][hh]; f32x4 x0 = (f32x4){bflo(v.x), bfhi(v.x), bflo(v.y), bfhi(v.y)}, x1 = (f32x4){bflo(v.z), bfhi(v.z), bflo(v.w), bfhi(v.w)};
                    if ((k4 & 1) == 0) {
#pragma unroll
                        for (int i = 0; i < 4; ++i) { x0[i] = __builtin_amdgcn_exp2f(x0[i]); x1[i] = __builtin_amdgcn_exp2f(x1[i]); } }
                    LAS float* dp = AF + (size_t)k4 * 8192 + (pr + 32 * hh) * 128 + c8; *(LAS f32x4*)dp = x0; *(LAS f32x4*)(dp + 4) = x1; }
            const u32x4 gcur0 = gg[0], gcur1 = gg[1];
            if (ti + 1 < 8) { L2_LOAD(ti + 1, cur, gg); }
            __syncthreads();
            if (F.wave < 4) {
                const int d = F.wave >> 1, ch = F.tid & 127;
                LAS float* Ad = AF + (size_t)(2 * d) * 8192 + ch; LAS float* Bd = AF + (size_t)(2 * d + 1) * 8192 + ch;
                float h = cin[0];
#pragma unroll
                for (int i = 1; i < 8; ++i) h = (ti == i) ? cin[i] : h;
#pragma unroll 8
                for (int s = 0; s < 64; ++s) { const int t = d ? 63 - s : s; const float a = Ad[t * 128], bb = Bd[t * 128]; h = a * h + bb; Bd[t * 128] = h; }
            }
            __syncthreads();
#pragma unroll
            for (int hh = 0; hh < 2; ++hh) { const int p = pr + 32 * hh;
                const LAS float* h0 = AF + 8192 + p * 128 + c8; const LAS float* h1 = AF + 3 * 8192 + p * 128 + c8;
                const f32x4 x0 = *(const LAS f32x4*)h0, x1 = *(const LAS f32x4*)(h0 + 4), y0 = *(const LAS f32x4*)h1, y1 = *(const LAS f32x4*)(h1 + 4);
                const u32x4 gv = hh ? gcur1 : gcur0;
                u32x4 o; o.x = pkbf((x0[0] + y0[0]) * bflo(gv.x), (x0[1] + y0[1]) * bfhi(gv.x)); o.y = pkbf((x0[2] + y0[2]) * bflo(gv.y), (x0[3] + y0[3]) * bfhi(gv.y));
                o.z = pkbf((x1[0] + y1[0]) * bflo(gv.z), (x1[1] + y1[1]) * bfhi(gv.z)); o.w = pkbf((x1[2] + y1[2]) * bflo(gv.w), (x1[3] + y1[3]) * bfhi(gv.w));
                *(u32x4*)(A1 + (size_t)(row0 + p) * D + g * 128 + c8) = o; }
            __syncthreads();
        }
#undef L2_LOAD
    }
}

constexpr int HG_QT = 0, HG_KT = 9216, HG_QH = 18432, HG_KHT = 27648, HG_VT = 36864, HG_PS = 55296, HG_ST0 = 64512, HG_ST1 = 82944, HG_SEG = 101376, HG_DEC = 105472;
constexpr int HG_INV = 139264;
constexpr int HS64 = 144;
#define HG_SYNC() asm volatile("s_waitcnt lgkmcnt(0)\n\ts_barrier" ::: "memory")
__device__ __forceinline__ void hgrn_phase(const Frame& F) {
    const bf16* PQ = (const bf16*)(F.ws + WS_P) + 2 * PG_STRIDE;
    const bf16* PV = (const bf16*)(F.ws + WS_P) + 5 * PG_STRIDE;
    LAS unsigned char* L = F.lds;
    const int fr = F.lane & 15, fq = F.lane >> 4, w = F.wave, lane = F.lane;
    if (F.tid < 32) ((LAS float*)(L + HG_INV))[F.tid] = ((const float*)(F.ws + WS_SW1))[32 + F.tid];
    __syncthreads();
    for (int it = F.vcu; it < 256; it += F.G) {
        const int dh = it & 1, dir = (it >> 1) & 1, h = (it >> 2) & 7, b = it >> 5;
        const bf16* PF = (const bf16*)(F.ws + WS_P) + (size_t)(3 + dir) * PG_STRIDE;
        bf16* OUT = (bf16*)(F.ws + (dir ? (dh ? WS_X1 + 32 * MiB : WS_OB) : (dh ? WS_X1 : WS_OF)));
        const int dp = lane & 31, ph = lane >> 5, d0 = 2 * dp;
        const int dcol = h * 128 + 64 * dh + d0;
        float lb0, lb1;
        { const float* ll = F.in[I_LBL]; const float a0 = ll[dcol], a1 = ll[dcol + 1], c0 = ll[D + dcol], c1 = ll[D + dcol + 1];
          lb0 = 1.0f / (1.0f + __expf(c0 - a0)); lb1 = 1.0f / (1.0f + __expf(c1 - a1)); }
        f32x4 S[4];
#pragma unroll
        for (int j = 0; j < 4; ++j) S[j] = (f32x4){0.f, 0.f, 0.f, 0.f};
#define HG_BASE(ci) ((ci) >= 4 ? b * SEQ + 64 * (dir ? 31 - ((ci) - 4) : ((ci) - 4)) : TL + b * CTXL + 64 * (dir ? 3 - (ci) : (ci)))
#define HG_LOAD(ci, FR, QR, VR) do { const int base_ = HG_BASE(ci); const bool lat_ = (ci) >= 4; \
        _Pragma("unroll") for (int i = 0; i < 4; ++i) { const int p_ = 8 * w + 4 * ph + i; const size_t ro_ = (size_t)(base_ + (dir ? 63 - p_ : p_)) * D + dcol; \
            FR[i] = *(const unsigned*)(PF + ro_); QR[i] = lat_ ? *(const unsigned*)(PQ + ro_) : 0u; } \
        _Pragma("unroll") for (int i = 0; i < 8; ++i) { const int p_ = 8 * w + i; VR[i] = *(const unsigned*)(PV + (size_t)(base_ + (dir ? 63 - p_ : p_)) * D + h * 128 + 2 * lane); } } while (0)
        unsigned fraw[4], qraw[4], vraw[8];
        HG_LOAD(0, fraw, qraw, vraw);
        unsigned fn[4], qn[4], vn[8];
        HG_LOAD(1, fn, qn, vn);
        float cs[4][2], kk[4][2];
#define HG_E1(FR) do { float run0_ = 0.f, run1_ = 0.f; \
        _Pragma("unroll") for (int i = 0; i < 4; ++i) { \
            const float f0_ = lb0 + (1.0f - lb0) * fast_sigmoid(bflo(FR[i])), f1_ = lb1 + (1.0f - lb1) * fast_sigmoid(bfhi(FR[i])); \
            run0_ += __builtin_amdgcn_logf(f0_); run1_ += __builtin_amdgcn_logf(f1_); \
            cs[i][0] = run0_; cs[i][1] = run1_; kk[i][0] = 1.0f - f0_; kk[i][1] = 1.0f - f1_; } \
        *(LAS f32x2*)(L + HG_SEG + ((2 * w + ph) * 64 + d0) * 4) = (f32x2){run0_, run1_}; } while (0)
        HG_E1(fraw);
        int pitem = -1;
        LAS unsigned char* fscr = L + 106496 + w * 4096;
        for (int ci = 0; ci < 36; ++ci) {
            const bool lat = ci >= 4;
            const int base = HG_BASE(ci);
            unsigned f2[4], q2[4], v2[8];
#pragma unroll
            for (int i = 0; i < 4; ++i) { f2[i] = 0u; q2[i] = 0u; }
#pragma unroll
            for (int i = 0; i < 8; ++i) v2[i] = 0u;
            const int fitem = ci * ((F.G < 256 ? F.G : 256) * NWAVES) + F.vcu * NWAVES + w;
            const bool fdo = fitem < MOE_ITEMS && it < F.G;
            if (pitem >= 0) { asm volatile("s_waitcnt vmcnt(0)" ::: "memory"); MoeItem pm_ = moe_item<false>(F, pitem); pm_.inv = ((const LAS float*)(L + HG_INV))[(pitem >> 11) & 31]; moe_dma_finish(pm_, lane, fscr); }
            if (ci + 2 < 36) { HG_LOAD(ci + 2, f2, q2, v2); }
            if (fdo) { moe_dma_issue(moe_item<false>(F, fitem), lane, fscr); }
            pitem = fdo ? fitem : -1;
            const int sidx = 2 * w + ph;
            HG_SYNC();
            float off0 = 0.f, off1 = 0.f, mid0 = 0.f, mid1 = 0.f, end0 = 0.f, end1 = 0.f;
            f32x2 sgv[16];
#pragma unroll
            for (int ww = 0; ww < 16; ++ww) sgv[ww] = *(const LAS f32x2*)(L + HG_SEG + (ww * 64 + d0) * 4);
            asm volatile("s_waitcnt lgkmcnt(0)" ::: "memory");
#pragma unroll
            for (int ww = 0; ww < 16; ++ww) { const f32x2 sg = sgv[ww];
                if (ww < sidx) { off0 += sg.x; off1 += sg.y; } if (ww < 8) { mid0 += sg.x; mid1 += sg.y; } end0 += sg.x; end1 += sg.y; }
            const float emid0 = __builtin_amdgcn_exp2f(mid0), emid1 = __builtin_amdgcn_exp2f(mid1);
            const float eem0 = __builtin_amdgcn_exp2f(end0 - mid0), eem1 = __builtin_amdgcn_exp2f(end1 - mid1);
            unsigned kh0[2], kh1[2];
            {
                float em[4][2], kt[4][2];
#pragma unroll
                for (int i = 0; i < 4; ++i) { const float g0 = off0 + cs[i][0], g1 = off1 + cs[i][1];
                    em[i][0] = __builtin_amdgcn_exp2f(g0 - mid0); em[i][1] = __builtin_amdgcn_exp2f(g1 - mid1);
                    kt[i][0] = kk[i][0] * __builtin_amdgcn_rcpf(em[i][0]); kt[i][1] = kk[i][1] * __builtin_amdgcn_rcpf(em[i][1]); }
                unsigned wq[4], wk[4], wh[4];
#pragma unroll
                for (int i = 0; i < 4; ++i) { const float qt0 = bflo(qraw[i]) * em[i][0], qt1 = bfhi(qraw[i]) * em[i][1];
                    wq[i] = pkbf(qt0, qt1); wk[i] = pkbf(kt[i][0], kt[i][1]); wh[i] = pkbf(qt0 * emid0, qt1 * emid1); }
                if (lat) {
#pragma unroll
                    for (int i = 0; i < 4; ++i) { const int p = 8 * w + 4 * ph + i;
                        *(LAS unsigned*)(L + HG_QT + p * HS64 + d0 * 2) = wq[i]; *(LAS unsigned*)(L + HG_KT + p * HS64 + d0 * 2) = wk[i]; *(LAS unsigned*)(L + HG_QH + p * HS64 + d0 * 2) = wh[i]; }
                }
                kh0[0] = pkbf(kt[0][0] * eem0, kt[1][0] * eem0); kh0[1] = pkbf(kt[2][0] * eem0, kt[3][0] * eem0);
                kh1[0] = pkbf(kt[0][1] * eem1, kt[1][1] * eem1); kh1[1] = pkbf(kt[2][1] * eem1, kt[3][1] * eem1);
            }
            const int spos = 32 * (w >> 2) + 16 * (w & 1) + 4 * ((w >> 1) & 1);
            *(LAS u32x2*)(L + HG_KHT + d0 * HS64 + (spos + 8 * ph) * 2) = (u32x2){kh0[0], kh0[1]};
            *(LAS u32x2*)(L + HG_KHT + (d0 + 1) * HS64 + (spos + 8 * ph) * 2) = (u32x2){kh1[0], kh1[1]};
            if (sidx == 0) *(LAS f32x2*)(L + HG_DEC + d0 * 4) = (f32x2){emid0 * eem0, emid1 * eem1};
            { u32x4 lo, hi;
              lo.x = (vraw[0] & 0xffffu) | (vraw[1] << 16); lo.y = (vraw[2] & 0xffffu) | (vraw[3] << 16); lo.z = (vraw[4] & 0xffffu) | (vraw[5] << 16); lo.w = (vraw[6] & 0xffffu) | (vraw[7] << 16);
              hi.x = (vraw[0] >> 16) | (vraw[1] & 0xffff0000u); hi.y = (vraw[2] >> 16) | (vraw[3] & 0xffff0000u); hi.z = (vraw[4] >> 16) | (vraw[5] & 0xffff0000u); hi.w = (vraw[6] >> 16) | (vraw[7] & 0xffff0000u);
              *(LAS u32x2*)(L + HG_VT + (2 * lane) * HS64 + spos * 2) = (u32x2){lo.x, lo.y}; *(LAS u32x2*)(L + HG_VT + (2 * lane) * HS64 + (spos + 8) * 2) = (u32x2){lo.z, lo.w};
              *(LAS u32x2*)(L + HG_VT + (2 * lane + 1) * HS64 + spos * 2) = (u32x2){hi.x, hi.y}; *(LAS u32x2*)(L + HG_VT + (2 * lane + 1) * HS64 + (spos + 8) * 2) = (u32x2){hi.z, hi.w}; }
            HG_SYNC();
            const int stoff = (ci & 1) ? HG_ST1 : HG_ST0, stnext = (ci & 1) ? HG_ST0 : HG_ST1;
            if (lat) {
                const int pt = w >> 1;
                bf16x8 ps[2], qh[2];
                {
                    bf16x8 qt[2];
#pragma unroll
                    for (int kq = 0; kq < 2; ++kq) { qt[kq] = *(const LAS bf16x8*)(L + HG_QT + (16 * pt + fr) * HS64 + kq * 64 + fq * 16); qh[kq] = *(const LAS bf16x8*)(L + HG_QH + (16 * pt + fr) * HS64 + kq * 64 + fq * 16); }
                    f32x4 sc[4];
#pragma unroll
                    for (int st = 0; st < 4; ++st) { sc[st] = (f32x4){0.f, 0.f, 0.f, 0.f};
#pragma unroll
                        for (int kq = 0; kq < 2; ++kq) { const bf16x8 xa = *(const LAS bf16x8*)(L + HG_KT + (16 * st + fr) * HS64 + kq * 64 + fq * 16);
                            sc[st] = __builtin_amdgcn_mfma_f32_16x16x32_bf16(xa, qt[kq], sc[st], 0, 0, 0); }
                        const int pp = 16 * pt + fr, s0 = 16 * st + 4 * fq;
#pragma unroll
                        for (int r = 0; r < 4; ++r) sc[st][r] = (s0 + r <= pp) ? sc[st][r] : 0.f; }
#pragma unroll
                    for (int kq = 0; kq < 2; ++kq) { const u32x4 t4 = (u32x4){pkbf(sc[2 * kq][0], sc[2 * kq][1]), pkbf(sc[2 * kq][2], sc[2 * kq][3]), pkbf(sc[2 * kq + 1][0], sc[2 * kq + 1][1]), pkbf(sc[2 * kq + 1][2], sc[2 * kq + 1][3])};
                        ps[kq] = __builtin_bit_cast(bf16x8, t4); }
                }
                const int p = 16 * pt + fr, tok = base + (dir ? 63 - p : p);
#pragma unroll
                for (int j = 0; j < 4; ++j) { const int et = (w & 1) * 4 + j;
                    f32x4 a = (f32x4){0.f, 0.f, 0.f, 0.f};
#pragma unroll
                    for (int kq = 0; kq < 2; ++kq) { const bf16x8 xa = *(const LAS bf16x8*)(L + HG_VT + (16 * et + fr) * HS64 + kq * 64 + fq * 16);
                        a = __builtin_amdgcn_mfma_f32_16x16x32_bf16(xa, ps[kq], a, 0, 0, 0); }
#pragma unroll
                    for (int kq = 0; kq < 2; ++kq) { const bf16x8 xa = *(const LAS bf16x8*)(L + stoff + (16 * et + fr) * HS64 + kq * 64 + fq * 16);
                        a = __builtin_amdgcn_mfma_f32_16x16x32_bf16(xa, qh[kq], a, 0, 0, 0); }
                    u32x2 wv; wv.x = pkbf(a[0], a[1]); wv.y = pkbf(a[2], a[3]);
                    *(u32x2*)(OUT + (size_t)tok * D + h * 128 + 16 * et + 4 * fq) = wv; }
            }
            { const int dt = w & 3;
              const f32x4 dc = *(const LAS f32x4*)(L + HG_DEC + (16 * dt + 4 * fq) * 4);
              bf16x8 xa[2];
#pragma unroll
              for (int kq = 0; kq < 2; ++kq) xa[kq] = *(const LAS bf16x8*)(L + HG_KHT + (16 * dt + fr) * HS64 + kq * 64 + fq * 16);
#pragma unroll
              for (int j = 0; j < 4; ++j) { const int et = (w >> 2) * 4 + j; S[j] = S[j] * dc;
#pragma unroll
                  for (int kq = 0; kq < 2; ++kq) { const bf16x8 yb = *(const LAS bf16x8*)(L + HG_VT + (16 * et + fr) * HS64 + kq * 64 + fq * 16);
                      S[j] = __builtin_amdgcn_mfma_f32_16x16x32_bf16(xa[kq], yb, S[j], 0, 0, 0); }
                  u32x2 wv; wv.x = pkbf(S[j][0], S[j][1]); wv.y = pkbf(S[j][2], S[j][3]);
                  *(LAS u32x2*)(L + stnext + (16 * et + fr) * HS64 + (16 * dt + 4 * fq) * 2) = wv; } }
            if (ci + 1 < 36) { HG_E1(fn); }
#pragma unroll
            for (int i = 0; i < 4; ++i) { fraw[i] = fn[i]; qraw[i] = qn[i]; fn[i] = f2[i]; qn[i] = q2[i]; }
#pragma unroll
            for (int i = 0; i < 8; ++i) { vraw[i] = vn[i]; vn[i] = v2[i]; }
        }
        if (pitem >= 0) { asm volatile("s_waitcnt vmcnt(0)" ::: "memory"); MoeItem pm_ = moe_item<false>(F, pitem); pm_.inv = ((const LAS float*)(L + HG_INV))[(pitem >> 11) & 31]; moe_dma_finish(pm_, lane, fscr); }
        HG_SYNC();
#undef HG_BASE
#undef HG_LOAD
#undef HG_E1
    }
}

__device__ __forceinline__ void p5_readout(const Frame& F) {
    const int gw = F.vcu * NWAVES + F.wave, NGW = F.G * NWAVES;
    const bf16* OFp = (const bf16*)(F.ws + WS_OF); const bf16* OBp = (const bf16*)(F.ws + WS_OB); const bf16* OF1 = (const bf16*)(F.ws + WS_X1); const bf16* OB1 = (const bf16*)(F.ws + WS_X1 + 32 * MiB);
    const bf16* SG = (const bf16*)(F.ws + WS_P) + 6 * PG_STRIDE; bf16* A2 = (bf16*)(F.ws + WS_A2);
    const float* gn = F.in[I_HGG];
    const int c0 = 16 * F.lane, e0 = c0 & 127;
    for (int r = gw; r < TL; r += NGW) {
        const size_t off = (size_t)r * D + c0;
        const u32x4 a0 = *(const u32x4*)(OFp + off), a1 = *(const u32x4*)(OFp + off + 8), b0 = *(const u32x4*)(OBp + off), b1 = *(const u32x4*)(OBp + off + 8);
        const u32x4 c0v = *(const u32x4*)(OF1 + off), c1v = *(const u32x4*)(OF1 + off + 8), d0v = *(const u32x4*)(OB1 + off), d1v = *(const u32x4*)(OB1 + off + 8);
        const u32x4 s0 = *(const u32x4*)(SG + off), s1 = *(const u32x4*)(SG + off + 8);
        const unsigned aa[8] = {a0.x, a0.y, a0.z, a0.w, a1.x, a1.y, a1.z, a1.w}, bb[8] = {b0.x, b0.y, b0.z, b0.w, b1.x, b1.y, b1.z, b1.w}, sg[8] = {s0.x, s0.y, s0.z, s0.w, s1.x, s1.y, s1.z, s1.w};
        const unsigned cc[8] = {c0v.x, c0v.y, c0v.z, c0v.w, c1v.x, c1v.y, c1v.z, c1v.w}, dd[8] = {d0v.x, d0v.y, d0v.z, d0v.w, d1v.x, d1v.y, d1v.z, d1v.w};
        float o[16]; float ss = 0.f;
#pragma unroll
        for (int q = 0; q < 8; ++q) { o[2 * q] = (bflo(aa[q]) + bflo(cc[q])) + (bflo(bb[q]) + bflo(dd[q])); o[2 * q + 1] = (bfhi(aa[q]) + bfhi(cc[q])) + (bfhi(bb[q]) + bfhi(dd[q])); ss += o[2 * q] * o[2 * q] + o[2 * q + 1] * o[2 * q + 1]; }
        ss += __shfl_xor(ss, 1); ss += __shfl_xor(ss, 2); ss += __shfl_xor(ss, 4);
        const float rstd = 1.0f / sqrtf(ss * (1.0f / 128.0f) + EPS);
        unsigned wv[8];
#pragma unroll
        for (int q = 0; q < 8; ++q) wv[q] = pk2(o[2 * q] * rstd * gn[e0 + 2 * q] * bflo(sg[q]), o[2 * q + 1] * rstd * gn[e0 + 2 * q + 1] * bfhi(sg[q]));
        *(u32x4*)(A2 + off) = (u32x4){wv[0], wv[1], wv[2], wv[3]}; *(u32x4*)(A2 + off + 8) = (u32x4){wv[4], wv[5], wv[6], wv[7]};
    }
}

constexpr int R9_HTS = 1028;
constexpr int R9_PART = 16 * R9_HTS * 4;
__device__ __forceinline__ void p9_route(const Frame& F) {
    LAS float* HT = (LAS float*)F.lds; LAS float* PART = (LAS float*)(F.lds + R9_PART);
    const int lane = F.lane, w = F.wave, fr = lane & 15, fq = lane >> 4;
    const bf16* X1 = (const bf16*)(F.ws + WS_X1); const float* mod = (const float*)(F.ws + WS_MOD); unsigned char* H2 = F.ws + WS_H2; float* SCL = (float*)(F.ws + WS_SCL);
    const float* g2 = F.in[I_N2G];
    unsigned* cnt = (unsigned*)(F.ws + WS_CTL) + CW_CNT;
    int* TE = (int*)(F.ws + WS_ROUTE); int* TP = TE + TL * 4; float* TG = (float*)(TP + TL * 4); int* LIST = (int*)(F.ws + WS_LIST);
    LAS unsigned* ALIST = (LAS unsigned*)(F.lds + 147456);
    LAS int* HIST = (LAS int*)(F.lds + 149504); LAS int* BASE = HIST + 32; LAS float* TSC = (LAS float*)(BASE + 32);
    if (F.tid < 32) HIST[F.tid] = 0;
    float bfr[8][4][2];
    { const float* rw = F.in[I_RW] + (size_t)(128 * w + 4 * fq) * 32 + fr;
#pragma unroll
      for (int S = 0; S < 8; ++S)
#pragma unroll
          for (int c = 0; c < 4; ++c)
#pragma unroll
              for (int et = 0; et < 2; ++et) bfr[S][c][et] = rw[(size_t)(16 * S + c) * 32 + et * 16]; }
    __syncthreads();
    const int e_l = lane & 31, hu = lane >> 5;
    const float rbias = F.in[I_RB][e_l];
    const int tpw = (TL + F.G - 1) / F.G, t0 = F.vcu * tpw, t1 = (t0 + tpw < TL) ? t0 + tpw : TL;
    int curb = -1; float gk[16], sk[16];
#pragma unroll
    for (int j = 0; j < 16; ++j) { gk[j] = 0.f; sk[j] = 0.f; }
    int n = 0;
    for (int tile0 = t0; tile0 < t1; tile0 += 16, n += 2) {
        const int tA = tile0 + w, tB = tile0 + 8 + w;
        const bool hasA = tA < t1, has2 = tB < t1;
        const int tt[2] = {hasA ? tA : t0, has2 ? tB : (hasA ? tA : t0)};
        if ((tt[0] >> 11) != curb) { curb = tt[0] >> 11; const float* mv = mod + (size_t)curb * NMOD;
#pragma unroll
            for (int j = 0; j < 4; ++j) { const int k = 4 * lane + 256 * j; const f32x4 gv = *(const f32x4*)(g2 + k), m4 = *(const f32x4*)(mv + 4 * D + k), m3 = *(const f32x4*)(mv + 3 * D + k);
#pragma unroll
                for (int i = 0; i < 4; ++i) { gk[4 * j + i] = gv[i] * (1.0f + m4[i]); sk[4 * j + i] = m3[i]; } } }
        float xv[2][16]; float ss[2] = {0.f, 0.f};
#pragma unroll
        for (int u = 0; u < 2; ++u)
#pragma unroll
            for (int j = 0; j < 4; ++j) { const u32x2 vb = *(const u32x2*)(X1 + (size_t)tt[u] * D + 4 * lane + 256 * j); const f32x4 v = (f32x4){bflo(vb.x), bfhi(vb.x), bflo(vb.y), bfhi(vb.y)};
#pragma unroll
                for (int i = 0; i < 4; ++i) { xv[u][4 * j + i] = v[i]; ss[u] += v[i] * v[i]; } }
        float rstd[2];
#pragma unroll
        for (int o = 1; o < 64; o <<= 1) { ss[0] += __shfl_xor(ss[0], o); ss[1] += __shfl_xor(ss[1], o); }
        rstd[0] = 1.0f / sqrtf(ss[0] * (1.0f / D) + EPS); rstd[1] = 1.0f / sqrtf(ss[1] * (1.0f / D) + EPS);
        float am0 = 0.f, am1 = 0.f;
#pragma unroll
        for (int j = 0; j < 16; ++j) { xv[0][j] = xv[0][j] * rstd[0] * gk[j] + sk[j]; xv[1][j] = xv[1][j] * rstd[1] * gk[j] + sk[j]; am0 = fmaxf(am0, fabsf(xv[0][j])); am1 = fmaxf(am1, fabsf(xv[1][j])); }
#pragma unroll
        for (int o = 1; o < 64; o <<= 1) { am0 = fmaxf(am0, __shfl_xor(am0, o)); am1 = fmaxf(am1, __shfl_xor(am1, o)); }
        const float sc0 = am0 > 0.f ? am0 * (1.0f / 127.0f) : 1.0f, sc1 = am1 > 0.f ? am1 * (1.0f / 127.0f) : 1.0f, iv0 = 1.0f / sc0, iv1 = 1.0f / sc1;
        if (lane == 0) { TSC[n * 8 + w] = sc0; TSC[(n + 1) * 8 + w] = sc1; }
#pragma unroll
        for (int j = 0; j < 4; ++j) {
            *(LAS f32x4*)(HT + w * R9_HTS + 4 * lane + 256 * j) = (f32x4){xv[0][4 * j], xv[0][4 * j + 1], xv[0][4 * j + 2], xv[0][4 * j + 3]};
            *(LAS f32x4*)(HT + (w + 8) * R9_HTS + 4 * lane + 256 * j) = (f32x4){xv[1][4 * j], xv[1][4 * j + 1], xv[1][4 * j + 2], xv[1][4 * j + 3]};
            unsigned w0 = 0u, w1 = 0u;
#pragma unroll
            for (int i = 0; i < 4; ++i) { w0 |= (unsigned)((int)rintf(xv[0][4 * j + i] * iv0) & 255) << (8 * i); w1 |= (unsigned)((int)rintf(xv[1][4 * j + i] * iv1) & 255) << (8 * i); }
            *(unsigned*)(H2 + (size_t)tt[0] * D + 4 * lane + 256 * j) = w0; *(unsigned*)(H2 + (size_t)tt[1] * D + 4 * lane + 256 * j) = w1; }
        __syncthreads();
        f32x4 acc[2]; acc[0] = (f32x4){0.f, 0.f, 0.f, 0.f}; acc[1] = (f32x4){0.f, 0.f, 0.f, 0.f};
#pragma unroll
        for (int S = 0; S < 8; ++S) { const f32x4 a4 = *(const LAS f32x4*)(HT + fr * R9_HTS + 128 * w + 16 * S + 4 * fq);
#pragma unroll
            for (int c = 0; c < 4; ++c)
#pragma unroll
                for (int et = 0; et < 2; ++et) acc[et] = __builtin_amdgcn_mfma_f32_16x16x4f32(a4[c], bfr[S][c][et], acc[et], 0, 0, 0); }
#pragma unroll
        for (int et = 0; et < 2; ++et)
#pragma unroll
            for (int r = 0; r < 4; ++r) PART[(w * 16 + 4 * fq + r) * 32 + et * 16 + fr] = acc[et][r];
        __syncthreads();
        float lg = rbias;
#pragma unroll
        for (int p = 0; p < 8; ++p) lg += PART[(p * 16 + w + 8 * hu) * 32 + e_l];
        float tv[4]; int te[4];
#pragma unroll
        for (int k4 = 0; k4 < 4; ++k4) {
            float bv = lg; int be = e_l;
#pragma unroll
            for (int o = 1; o < 32; o <<= 1) { const float ov = __shfl_xor(bv, o); const int oe = __shfl_xor(be, o); if (ov > bv || (ov == bv && oe < be)) { bv = ov; be = oe; } }
            tv[k4] = bv; te[k4] = be; if (e_l == be) lg = -3.0e38f;
        }
        {
            const bool act_ = hu ? has2 : hasA; const int tok = hu ? tB : tA;
            const float p1 = __expf(tv[1] - tv[0]), p2 = __expf(tv[2] - tv[0]), p3 = __expf(tv[3] - tv[0]); const float inv = 1.0f / (1.0f + p1 + p2 + p3);
            if (e_l < 4 && act_) { const int e = e_l == 0 ? te[0] : e_l == 1 ? te[1] : e_l == 2 ? te[2] : te[3];
                const float gt = (e_l == 0 ? 1.0f : e_l == 1 ? p1 : e_l == 2 ? p2 : p3) * inv;
                const int rank = __hip_atomic_fetch_add(HIST + e, 1, __ATOMIC_RELAXED, __HIP_MEMORY_SCOPE_WORKGROUP);
                ALIST[((n + hu) * 8 + w) * 4 + e_l] = (unsigned)e | ((unsigned)rank << 8);
                TE[tok * 4 + e_l] = e; TG[tok * 4 + e_l] = gt; }
        }
    }
    __syncthreads();
    if (F.tid < 32) BASE[F.tid] = (int)__hip_atomic_fetch_add(cnt + 64 * F.tid, (unsigned)HIST[F.tid], __ATOMIC_RELAXED, __HIP_MEMORY_SCOPE_AGENT);
    __syncthreads();
    n = 0;
    for (int t = t0 + w; t < t1; t += 8, ++n) {
        if (lane < 4) { const unsigned ent = ALIST[(n * 8 + w) * 4 + lane]; const int e = (int)(ent & 255u), pos = BASE[e] + (int)(ent >> 8);
            LIST[(size_t)e * TL + pos] = t; TP[t * 4 + lane] = pos; SCL[(size_t)e * TL + pos] = TSC[n * 8 + w]; }
    }
    __syncthreads();
}
__device__ __forceinline__ void moe_tables(const Frame& F, volatile LAS int* tab) {
    if (F.tid < 64) {
        const unsigned* cnt = (const unsigned*)(F.ws + WS_CTL) + CW_CNT; const int e = F.tid & 31;
        const int n = (int)__hip_atomic_load(cnt + 64 * e, __ATOMIC_RELAXED, __HIP_MEMORY_SCOPE_AGENT);
        const int t = (n + 255) >> 8; int run = t;
#pragma unroll
        for (int o = 1; o < 32; o <<= 1) { const int v = __shfl_up(run, o); if (e >= o) run += v; }
        if (F.tid < 32) { tab[e] = run - t; tab[64 + e] = n; if (e == 31) tab[32] = run; }
    }
    __syncthreads();
}
__device__ __forceinline__ void p12_final(const Frame& F, volatile LAS int* tab) {
    const int gw = F.vcu * NWAVES + F.wave, NGW = F.G * NWAVES, lane = F.lane;
    const bf16* X1 = (const bf16*)(F.ws + WS_X1); const float* mod = (const float*)(F.ws + WS_MOD); const bf16* Y = (const bf16*)(F.ws + WS_Y);
    const int* TE = (const int*)(F.ws + WS_ROUTE); const int* TP = TE + TL * 4; const float* TG = (const float*)(TP + TL * 4);
    const float* fg = F.in[I_FG];
    f32x4 fgv[4];
#pragma unroll
    for (int j = 0; j < 4; ++j) fgv[j] = *(const f32x4*)(fg + 4 * lane + 256 * j);
    for (int tb = gw; tb < TL; tb += 2 * NGW) {
        const bool has2 = tb + NGW < TL;
        const int tt[2] = {tb, has2 ? tb + NGW : tb};
        size_t yoff[2][4]; float gt[2][4];
#pragma unroll
        for (int u = 0; u < 2; ++u)
#pragma unroll
            for (int k4 = 0; k4 < 4; ++k4) { const int e = TE[tt[u] * 4 + k4], pos = TP[tt[u] * 4 + k4]; gt[u][k4] = TG[tt[u] * 4 + k4]; yoff[u][k4] = ((size_t)tab[e] * 256 + pos) * D + 4 * lane; }
        f32x4 xa[2][4], gm[2][4]; u32x2 yv[2][4][4];
#pragma unroll
        for (int u = 0; u < 2; ++u) { const float* mv = mod + (size_t)(tt[u] >> 11) * NMOD + 5 * D;
#pragma unroll
            for (int j = 0; j < 4; ++j) { const u32x2 xb = *(const u32x2*)(X1 + (size_t)tt[u] * D + 4 * lane + 256 * j); xa[u][j] = (f32x4){bflo(xb.x), bfhi(xb.x), bflo(xb.y), bfhi(xb.y)}; gm[u][j] = *(const f32x4*)(mv + 4 * lane + 256 * j);
#pragma unroll
                for (int k4 = 0; k4 < 4; ++k4) yv[u][k4][j] = *(const u32x2*)(Y + yoff[u][k4] + 256 * j); } }
#pragma unroll
        for (int u = 0; u < 2; ++u) {
            f32x4 xv[4]; float ss = 0.f;
#pragma unroll
            for (int j = 0; j < 4; ++j) { f32x4 m = (f32x4){0.f, 0.f, 0.f, 0.f};
#pragma unroll
                for (int k4 = 0; k4 < 4; ++k4) { const u32x2 y = yv[u][k4][j]; const float g = gt[u][k4]; m += (f32x4){bflo(y.x), bfhi(y.x), bflo(y.y), bfhi(y.y)} * g; }
                xv[j] = xa[u][j] + gm[u][j] * m; ss += (xv[j][0] * xv[j][0] + xv[j][1] * xv[j][1]) + (xv[j][2] * xv[j][2] + xv[j][3] * xv[j][3]); }
            const float rstd = 1.0f / sqrtf(wave_sum(ss) * (1.0f / D) + EPS);
            if (u == 0 || has2) {
#pragma unroll
                for (int j = 0; j < 4; ++j) *(f32x4*)(F.out + (size_t)tt[u] * D + 4 * lane + 256 * j) = xv[j] * rstd * fgv[j]; }
        }
    }
}
__global__ void __launch_bounds__(NWAVES * 64, 2) fwd(Args args) {
    extern __shared__ __attribute__((aligned(16))) unsigned char lds[];
    Frame F;
    F.lds = (LAS unsigned char*)lds; F.tid = threadIdx.x; F.lane = F.tid & 63; F.wave = __builtin_amdgcn_readfirstlane(F.tid >> 6);
    F.G = gridDim.x; { const int bx = blockIdx.x; F.vcu = (F.G % 8 == 0) ? (bx % 8) * (F.G / 8) + bx / 8 : bx; }
    F.ws = args.ws; F.in = args.in; F.out = args.out;
    volatile LAS unsigned* MISC = (volatile LAS unsigned*)(F.lds + LDS_MISC);
    volatile LAS int* TAB = (volatile LAS int*)(F.lds + LDS_MISC + 64);
    for (int u = F.tid; u < (LDS_BYTES - LDS_MISC) / 4; u += NWAVES * 64) MISC[u] = 0u;
    __syncthreads();
    unsigned* ctl = (unsigned*)(F.ws + WS_CTL);
    XcdBarrier bar; bar.bar = ctl + CW_BAR; bar.x = 0; bar.st = nullptr;
    if (MK_N_LAUNCHES == 1) bar = xcd_barrier_post(ctl + CW_BAR, MISC);
#define GRID_BAR() do { if (MK_N_LAUNCHES == 1) xcd_barrier(bar); } while (0)
    const int lo = args.ph_lo, hi = args.ph_hi;
#ifndef PH_MASK
#define PH_MASK 0x1fff
#endif
#define IN(k) (((PH_MASK >> (k)) & 1) && lo <= (k) && (k) < hi)
#define BOTH(k) (IN(k) && IN((k) + 1))
    const int cid = (int)blockIdx.x;

#ifndef DUP_MASK
#define DUP_MASK 0
#endif
#define REPS(k) ((((DUP_MASK) >> (k)) & 1) ? 2 : 1)
#define REP_LOOP(k) _Pragma("unroll") for (int rep_ = 0; rep_ < REPS(k); ++rep_)
#define REP_SEP(k) do { if (rep_ + 1 < REPS(k)) { GRID_BAR(); if ((k) == 9) { if (blockIdx.x == 0 && F.tid < 32) __hip_atomic_store(ctl + CW_CNT + 64 * F.tid, 0u, __ATOMIC_RELAXED, __HIP_MEMORY_SCOPE_AGENT); GRID_BAR(); } } } while (0)
    if (IN(0)) { REP_LOOP(0) { p0_prologue(F); REP_SEP(0); } if (BOTH(0)) GRID_BAR(); }
    if (IN(1)) { REP_LOOP(1) { p1_norm(F); REP_SEP(1); } if (BOTH(1)) GRID_BAR(); }
    if (IN(2)) {
        SchedInproj S{(const char*)(F.ws + WS_H), (const char*)(F.ws + WS_WIN), F.G, cid};
        EpiInproj E{(bf16*)(F.ws + WS_P), (const float*)(F.ws + WS_HS), (const float*)(F.ws + WS_WINS)};
        SchedCached<SchedInproj> SC{S, F.lds}; SC.init(F.tid);
        REP_LOOP(2) { pg8::gemm_phase<EpiInproj, SchedCached<SchedInproj>, true, true>(F.lds, D, SC, E); REP_SEP(2); }
        if (F.G != 256) {
            LAS float* scr = (LAS float*)(F.lds + F.wave * 16384);
            const int FW = (F.G < 256 ? F.G : 256) * NWAVES;
            for (int it = 36 * FW + F.vcu * NWAVES + F.wave; it < MOE_ITEMS; it += F.G * NWAVES) { const MoeItem m = moe_item(F, it); float tv[16]; moe_conv_issue(m, F.lane, tv); moe_conv_finish(m, F.lane, tv, scr); }
            __syncthreads();
        }
        if (F.G == 256 && cid >= 128) {
            LAS float* scr = (LAS float*)(F.lds + F.wave * 16384);
            const int first = 36 * 256 * NWAVES + (cid - 128) * NWAVES + F.wave, stride = 128 * NWAVES;
            float tv[16], tn[16]; MoeItem m = moe_item(F, first < MOE_ITEMS ? first : 0), mn = m;
            if (first < MOE_ITEMS) moe_conv_issue(m, F.lane, tv);
            for (int it = first; it < MOE_ITEMS; it += stride) {
                const bool more = it + stride < MOE_ITEMS;
                if (more) { mn = moe_item(F, it + stride); moe_conv_issue(mn, F.lane, tn); }
                moe_conv_finish(m, F.lane, tv, scr);
                m = mn;
#pragma unroll
                for (int i = 0; i < 16; ++i) tv[i] = tn[i];
            }
            __syncthreads();
        }
        if (BOTH(2)) GRID_BAR();
    }
    if (IN(3)) { REP_LOOP(3) { lru_phase<1>(F, F.vcu, F.G); REP_SEP(3); } if (BOTH(3)) GRID_BAR(); }
    if (IN(4)) { REP_LOOP(13) { hgrn_phase(F); REP_SEP(13); } REP_LOOP(14) { lru_pass2_stream(F, F.vcu, F.G); REP_SEP(14); } if (BOTH(4)) GRID_BAR(); }
    if (IN(5)) {
        SchedSq S{(const char*)(F.ws + WS_A1), (const char*)(F.ws + WS_WBA), F.G, cid};
        EpiMerge<0> E{(bf16*)(F.ws + WS_T1), (const bf16*)(F.ws + WS_P) + 7 * PG_STRIDE, nullptr};
        REP_LOOP(6) { pg8::gemm_phase<EpiMerge<0>, SchedSq, false>(F.lds, D, S, E); REP_SEP(6); }
    }
    if (IN(6)) { REP_LOOP(5) { p5_readout(F); REP_SEP(5); } if (BOTH(6)) GRID_BAR(); }
    if (IN(7)) {
        SchedSq S{(const char*)(F.ws + WS_A2), (const char*)(F.ws + WS_WBB), F.G, cid};
        EpiMerge<1> E{(bf16*)(F.ws + WS_MM), (const bf16*)(F.ws + WS_P) + 8 * PG_STRIDE, (const bf16*)(F.ws + WS_T1)};
        REP_LOOP(7) { pg8::gemm_phase<EpiMerge<1>, SchedSq, false>(F.lds, D, S, E); REP_SEP(7); }
        if (BOTH(7)) GRID_BAR();
    }
    if (IN(8)) {
        SchedSq S{(const char*)(F.ws + WS_MM), (const char*)(F.ws + WS_WOUT), F.G, cid};
        EpiX1 E{(bf16*)(F.ws + WS_X1), F.in[I_X], (const float*)(F.ws + WS_MOD)};
        REP_LOOP(8) { pg8::gemm_phase<EpiX1, SchedSq, false>(F.lds, D, S, E); REP_SEP(8); }
        if (BOTH(8)) GRID_BAR();
    }
    if (IN(9)) { REP_LOOP(9) { p9_route(F); REP_SEP(9); } if (BOTH(9)) GRID_BAR(); }
    if (IN(10)) {
        moe_tables(F, TAB);
        SchedMoe<8, true> S{(const char*)(F.ws + WS_H2), (const char*)(F.ws + WS_W1), (const int*)(F.ws + WS_LIST), TAB, F.G, F.vcu, D};
        EpiAct E{(bf16*)(F.ws + WS_ACT), F.in[I_B1], (const float*)(F.ws + WS_SCL), (const float*)(F.ws + WS_SW1)};
        REP_LOOP(10) { pg8::gemm_phase<EpiAct, SchedMoe<8, true>, true, true>(F.lds, D, S, E); REP_SEP(10); }
        if (BOTH(10)) GRID_BAR();
    }
    if (IN(11)) {
        moe_tables(F, TAB);
        SchedMoe<4, false> S{(const char*)(F.ws + WS_ACT), (const char*)(F.ws + WS_W2), nullptr, TAB, F.G, F.vcu, 2 * D};
        EpiY E{(bf16*)(F.ws + WS_Y), F.in[I_B2]};
        SchedCached<SchedMoe<4, false>> SC{S, F.lds}; SC.init(F.tid);
        REP_LOOP(11) { pg8::gemm_phase<EpiY, SchedCached<SchedMoe<4, false>>, true>(F.lds, D, SC, E); REP_SEP(11); }
        if (BOTH(11)) GRID_BAR();
    }
    if (IN(12)) { moe_tables(F, TAB); REP_LOOP(12) { p12_final(F, TAB); REP_SEP(12); } }
#undef IN
#undef BOTH
#undef GRID_BAR
}

extern "C" void kernel_launch(void* const* d_in, const int* in_sizes, int n_in, void* d_out, int out_size, void* d_ws, size_t ws_size, hipStream_t stream) {
    static int grid = 0;
    if (grid == 0) {
        if (n_in != 28 || in_sizes[0] != TL * D || out_size != TL * D || ws_size < WS_END) { fprintf(stderr, "kernel_launch: unexpected shapes (n_in %d, in0 %d, out %d, ws %zu)\n", n_in, n_in > 0 ? in_sizes[0] : -1, out_size, ws_size); grid = -1; return; }
        int dev = 0, cus = 0, per_cu = 0;
        if (hipGetDevice(&dev) != hipSuccess || hipDeviceGetAttribute(&cus, hipDeviceAttributeMultiprocessorCount, dev) != hipSuccess) { grid = -1; return; }
        if (hipFuncSetAttribute((const void*)fwd, hipFuncAttributeMaxDynamicSharedMemorySize, LDS_BYTES) != hipSuccess) { fprintf(stderr, "kernel_launch: hipFuncSetAttribute failed\n"); grid = -1; return; }
        if (hipOccupancyMaxActiveBlocksPerMultiprocessor(&per_cu, (const void*)fwd, NWAVES * 64, LDS_BYTES) != hipSuccess || per_cu < 1) { fprintf(stderr, "kernel_launch: occupancy query reports %d\n", per_cu); }
        (void)hipGetLastError();
        grid = cus;
    }
    if (grid < 0) return;
    if (hipMemsetAsync((char*)d_ws + WS_CTL, 0, CTL_ZERO_BYTES, stream) != hipSuccess) return;
    Args a{};
    for (int i = 0; i < 28; ++i) a.in[i] = (const float*)d_in[i];
    a.out = (float*)d_out; a.ws = (unsigned char*)d_ws;
    if (MK_N_LAUNCHES == 1) {
        a.ph_lo = 0; a.ph_hi = NPH;
        hipLaunchKernelGGL(fwd, dim3(grid), dim3(NWAVES * 64), LDS_BYTES, stream, a);
    } else {
        for (int p = 0; p < NPH; ++p) { a.ph_lo = p; a.ph_hi = p + 1; hipLaunchKernelGGL(fwd, dim3(grid), dim3(NWAVES * 64), LDS_BYTES, stream, a); }
    }
}
```

```cpp
#include <hip/hip_runtime.h>
#include <cstdio>
#include <cstdint>

#ifndef MK_N_LAUNCHES
#define MK_N_LAUNCHES 1
#endif

#define GAS __attribute__((address_space(1)))
#define LAS __attribute__((address_space(3)))
typedef unsigned short bf16;
typedef short bf16x8 __attribute__((ext_vector_type(8)));
typedef float f32x4 __attribute__((ext_vector_type(4)));
typedef float f32x2 __attribute__((ext_vector_type(2)));
typedef unsigned u32x4 __attribute__((ext_vector_type(4)));
typedef unsigned u32x2 __attribute__((ext_vector_type(2)));
typedef int i32x4 __attribute__((ext_vector_type(4)));

constexpr int NB = 8, SEQ = 2048, CTXL = 256, D = 1024;
constexpr int TL = NB * SEQ;
constexpr int TC = NB * CTXL;
constexpr int TT = TL + TC;
constexpr int NMOD = 6 * D;
constexpr int NE = 32;
constexpr float EPS = 1e-6f;
constexpr int NPH = 13;
constexpr int NWAVES = 8;

constexpr size_t MiB = 1u << 20;
constexpr size_t WS_CTL = 0, CTL_ZERO_BYTES = 1 * MiB;
constexpr size_t WS_MOD = 1 * MiB;
constexpr size_t WS_SPL = 1 * MiB + 512 * 1024;
constexpr size_t WS_ROUTE = 2 * MiB;
constexpr size_t WS_LIST = 3 * MiB;
constexpr size_t WS_AGG = 5 * MiB;
constexpr size_t WS_LRUW = 10 * MiB;
constexpr size_t WS_WBA = 12 * MiB, WS_WBB = 14 * MiB, WS_WOUT = 16 * MiB;
constexpr size_t WS_WIN = 18 * MiB;
constexpr size_t WS_W1 = 36 * MiB;
constexpr size_t WS_W2 = 164 * MiB;
constexpr size_t WS_H = 228 * MiB;
constexpr size_t WS_HS = 248 * MiB;
constexpr size_t WS_WINS = 30 * MiB;
constexpr size_t WS_P = 264 * MiB;
constexpr size_t PG_STRIDE = (size_t)TT * D;
constexpr size_t WS_A1 = 588 * MiB, WS_OF = 620 * MiB, WS_OB = 652 * MiB, WS_A2 = 684 * MiB, WS_T1 = 716 * MiB, WS_MM = 748 * MiB;
constexpr size_t WS_X1 = 780 * MiB;
constexpr size_t WS_H2 = 844 * MiB;
constexpr size_t WS_H2S = 864 * MiB;
constexpr size_t WS_SCL = 32 * MiB;
constexpr size_t WS_SW1 = 1 * MiB + 768 * 1024;
constexpr size_t WS_YP = 876 * MiB;
constexpr size_t WS_END = 972 * MiB;
constexpr size_t WS_ACT = WS_P;
constexpr size_t WS_Y = WS_P + 160 * MiB;
static_assert(WS_Y + (size_t)73728 * 1024 * 2 <= WS_A1, "overlay");
constexpr int CW_BAR = 4096;
constexpr int CW_CNT = 16384;

constexpr int RING_BYTES = 131072;
constexpr int SCLZ_OFF = 139264;
constexpr int GROW_OFF = 131072;
constexpr int LDS_MISC = 158720;
constexpr int LDS_BYTES = 159744;

#define LDS_WAIT() asm volatile("s_waitcnt lgkmcnt(0)" ::: "memory")
#define VM_WAIT() asm volatile("s_waitcnt vmcnt(0)" ::: "memory")

__device__ __forceinline__ float bf2f(unsigned b) { return __uint_as_float(b << 16); }
__device__ __forceinline__ float bflo(unsigned w) { return __uint_as_float(w << 16); }
__device__ __forceinline__ float bfhi(unsigned w) { return __uint_as_float(w & 0xffff0000u); }
typedef __bf16 nbf16x2 __attribute__((ext_vector_type(2)));
__device__ __forceinline__ unsigned f2bf(float f) { return (unsigned)__builtin_bit_cast(unsigned short, (__bf16)f); }
__device__ __forceinline__ unsigned pkbf(float lo, float hi) { nbf16x2 v; v[0] = (__bf16)lo; v[1] = (__bf16)hi; return __builtin_bit_cast(unsigned, v); }
__device__ __forceinline__ unsigned pk2(float lo, float hi) { return pkbf(lo, hi); }
__device__ __forceinline__ float wave_sum(float v) {
#pragma unroll
    for (int o = 1; o < 64; o <<= 1) v += __shfl_xor(v, o);
    return v;
}
__device__ __forceinline__ float fast_sigmoid(float z) { return __builtin_amdgcn_rcpf(1.0f + __builtin_amdgcn_exp2f(-1.44269504089f * z)); }

#define XB_TMO      128
#define XB_XCNT(j)  (256  + 64 * (j))
#define XB_XSUB(j)  (1280 + 64 * (j))
#define XB_XGEN(j)  (2304 + 64 * (j))
#define XB_TOP      3328
#define XB_TOPGEN   3392
#define XCD_BAR_WORDS 3456
#define XB_SPIN_CAP (1u << 18)

__device__ __forceinline__ unsigned xb_ld(unsigned* p)              { return __hip_atomic_load(p, __ATOMIC_RELAXED, __HIP_MEMORY_SCOPE_AGENT); }
__device__ __forceinline__ unsigned xb_add(unsigned* p, unsigned v) { return __hip_atomic_fetch_add(p, v, __ATOMIC_RELAXED, __HIP_MEMORY_SCOPE_AGENT); }
__device__ __forceinline__ unsigned xb_xcc_id() { return (unsigned)__builtin_amdgcn_s_getreg((3 << 11) | 20) & 0xFu; }
#define XB_SPIN(cond, bar) do { unsigned _sp = 0; while (cond) { __builtin_amdgcn_s_sleep(1); \
    if ((++_sp & 255u) == 0u) { if (xb_ld(&(bar)[XB_TMO])) break; if (_sp > XB_SPIN_CAP) { atomicAdd(&(bar)[XB_TMO], 1u); break; } } } } while (0)

struct XcdBarrier { unsigned* bar; unsigned x; volatile LAS unsigned* st; };

__device__ __forceinline__ XcdBarrier xcd_barrier_post(unsigned* bar, volatile LAS unsigned* st) {
    XcdBarrier b; b.bar = bar; b.x = xb_xcc_id(); b.st = st;
    if (threadIdx.x == 0) (void)xb_add(&bar[XB_XCNT(b.x)], 1u);
    return b;
}
__device__ __forceinline__ void xcd_barrier_complete(unsigned* bar, unsigned x, unsigned& nloc, unsigned& nx) {
    const unsigned G = gridDim.x * gridDim.y * gridDim.z;
    unsigned sum, cnt, mine, sp = 0u;
    for (;;) {
        sum = 0u; cnt = 0u; mine = 0u;
#pragma unroll
        for (unsigned j = 0; j < 16; ++j) { const unsigned c = xb_ld(&bar[XB_XCNT(j)]); sum += c; cnt += (c > 0u) ? 1u : 0u; mine = (j == x) ? c : mine; }
        if (sum == G) break;
        __builtin_amdgcn_s_sleep(1);
        if ((++sp & 255u) == 0u) { if (xb_ld(&bar[XB_TMO])) break; if (sp > XB_SPIN_CAP) { atomicAdd(&bar[XB_TMO], 1u); break; } }
    }
    nloc = mine > 0u ? mine : 1u; nx = cnt > 0u ? cnt : 1u;
}
__device__ __forceinline__ void xcd_barrier(const XcdBarrier& b) {
    asm volatile("s_waitcnt vmcnt(0)" ::: "memory");
    __syncthreads();
    if (threadIdx.x == 0) {
        unsigned* bar = b.bar;
        __builtin_amdgcn_s_waitcnt(0);
        unsigned nloc = b.st[0], nx = b.st[1];
        if (nloc == 0u) { xcd_barrier_complete(bar, b.x, nloc, nx); b.st[0] = nloc; b.st[1] = nx; }
        const unsigned old = xb_add(&bar[XB_XSUB(b.x)], 1u);
        const unsigned gen = old / nloc;
        if (old + 1u == (gen + 1u) * nloc) {
            __builtin_amdgcn_fence(__ATOMIC_RELEASE, "agent");
            asm volatile("s_waitcnt vmcnt(0)" ::: "memory");
            const unsigned og = xb_add(&bar[XB_TOP], 1u);
            const unsigned tg = og / nx;
            if (og + 1u == (tg + 1u) * nx) xb_add(&bar[XB_TOPGEN], 1u);
            else XB_SPIN(xb_ld(&bar[XB_TOPGEN]) == tg, bar);
            __builtin_amdgcn_fence(__ATOMIC_ACQUIRE, "agent");
            asm volatile("s_waitcnt vmcnt(0)" ::: "memory");
        } else {
            XB_SPIN(xb_ld(&bar[XB_TOPGEN]) == gen, bar);
            __builtin_amdgcn_fence(__ATOMIC_ACQUIRE, "agent");
            asm volatile("s_waitcnt vmcnt(0)" ::: "memory");
        }
    }
    __syncthreads();
}

namespace pg8 {
constexpr int BM = 256, BK = 64, HALF = 128, HTB = HALF * BK * 2, STAGE_BYTES = 8 * HTB;
__host__ __device__ __forceinline__ int lds_byte(int r, int c) { const int st = (r >> 4) * 2 + (c >> 5), rr = r & 15, cc = c & 31, ob = rr * 64 + cc * 2; return st * 1024 + (ob ^ (((ob >> 9) & 1) << 5)); }
__host__ __device__ __forceinline__ void stage_rc(int b, int& R, int& C) { const int st = b / 1024, sb = b % 1024, swz = sb ^ (((sb >> 9) & 1) << 5); R = (st >> 1) * 16 + swz / 64; C = (st & 1) * 32 + (swz % 64) / 2; }
__host__ __device__ __forceinline__ int perm32(int rho) { const int n = rho >> 4, i = rho & 15; return 8 * (i >> 2) + 4 * n + (i & 3); }

struct Unit { const char* A; const char* B; int pm, pn, e, aux, idx, nt, part, lu; };

__device__ __forceinline__ unsigned cvt_pk_bf16(float lo, float hi) { unsigned r; asm volatile("v_cvt_pk_bf16_f32 %0, %1, %2" : "=v"(r) : "v"(lo), "v"(hi)); return r; }

__device__ __forceinline__ void rect_order(int wgid, int nM, int nN, int& pm, int& pn) {
    const int nwg = nM * nN; constexpr int NXCD = 8, WGM = 8;
    { const int q = nwg / NXCD, r = nwg % NXCD, xcd = wgid % NXCD, off = wgid / NXCD; wgid = (xcd < r ? xcd * (q + 1) : r * (q + 1) + (xcd - r) * q) + off; }
    const int nig = WGM * nN, gid = wgid / nig, fm = gid * WGM, gsz = (nM - fm) < WGM ? (nM - fm) : WGM;
    pm = fm + ((wgid % nig) % gsz); pn = (wgid % nig) / gsz;
}

template <bool I8> struct AccSel { typedef f32x4 type; };
template <> struct AccSel<true> { typedef i32x4 type; };
template <class Epi, class Sched, bool ALIGN_EPI, bool I8 = false>
__device__ __forceinline__ void gemm_phase(LAS unsigned char* lds, const int K, const Sched& S, const Epi& E) {
    typedef typename AccSel<I8>::type AccT;
    const int PB = I8 ? K : 2 * K;
    const int tid = threadIdx.x, wid = __builtin_amdgcn_readfirstlane(tid >> 6), lane = tid & 63, wr = wid >> 2, wc = wid & 3, fr = lane & 15, fq = lane >> 4;
    const int nt = PB / 128;
    int RA[2], CA[2]; unsigned voffB[2];
#pragma unroll
    for (int i = 0; i < 2; ++i) { int R, C; stage_rc(tid * 16 + i * 8192, R, C); const int Rb = Epi::PERM ? ((R & ~31) + perm32(R & 31)) : R;
        RA[i] = R; CA[i] = C; voffB[i] = (unsigned)(Rb * PB + C * 2); }
    const size_t kstep = 128;
    const size_t hstep = (size_t)HALF * PB;
    const unsigned ldsw = (unsigned)wid * 1024u;
    const int aoff = lds_byte(wr * 64 + fr, fq * 8), boff = lds_byte(wc * 32 + fr, fq * 8);
#define PG8_SA(b, h) (((b) * 2 + (h)) * HTB)
#define PG8_SB(b, h) ((4 + (b) * 2 + (h)) * HTB)
#define PG8_STAGE_B(bufoff, gbase) do { _Pragma("unroll") for (int _i = 0; _i < 2; ++_i) \
        __builtin_amdgcn_global_load_lds((const unsigned*)((const char*)(gbase) + voffB[_i]), (LAS unsigned*)(lds + (bufoff) + ldsw + _i * 8192), 16, 0, 0); } while (0)
#define PG8_STAGE_A(bufoff, gbase, o0, o1) do { \
        __builtin_amdgcn_global_load_lds((const unsigned*)((const char*)(gbase) + (o0)), (LAS unsigned*)(lds + (bufoff) + ldsw), 16, 0, 0); \
        __builtin_amdgcn_global_load_lds((const unsigned*)((const char*)(gbase) + (o1)), (LAS unsigned*)(lds + (bufoff) + ldsw + 8192), 16, 0, 0); } while (0)
#define PG8_LDA(dst, b, h) do { _Pragma("unroll") for (int m = 0; m < 4; ++m) _Pragma("unroll") for (int k = 0; k < 2; ++k) dst[m][k] = *(const LAS bf16x8*)(lds + PG8_SA(b, h) + aoff + m * 2048 + k * 1024); } while (0)
#define PG8_LDB(dst, b, h) do { _Pragma("unroll") for (int n = 0; n < 2; ++n) _Pragma("unroll") for (int k = 0; k < 2; ++k) dst[n][k] = *(const LAS bf16x8*)(lds + PG8_SB(b, h) + boff + n * 2048 + k * 1024); } while (0)
#define PG8_MMA(ai, bj, At, Bt) do { __builtin_amdgcn_s_setprio(1); _Pragma("unroll") for (int m = 0; m < 4; ++m) _Pragma("unroll") for (int n = 0; n < 2; ++n) _Pragma("unroll") for (int k = 0; k < 2; ++k) \
        { if constexpr (I8) acc[ai][bj][m][n] = __builtin_amdgcn_mfma_i32_16x16x64_i8(__builtin_bit_cast(i32x4, Bt[n][k]), __builtin_bit_cast(i32x4, At[m][k]), acc[ai][bj][m][n], 0, 0, 0); \
          else acc[ai][bj][m][n] = __builtin_amdgcn_mfma_f32_16x16x32_bf16(Bt[n][k], At[m][k], acc[ai][bj][m][n], 0, 0, 0); } __builtin_amdgcn_s_setprio(0); } while (0)
#define PG8_WAIT_V(n) asm volatile("s_waitcnt vmcnt(" #n ")" ::: "memory")
#define PG8_WAIT_L(n) asm volatile("s_waitcnt lgkmcnt(" #n ")" ::: "memory")
#define PG8_BAR __builtin_amdgcn_s_barrier()
#define PG8_SCHED __builtin_amdgcn_sched_barrier(0)
    Unit cur, nxt; int ui = 0;
    if (!S.next(0, cur)) return;
    int cnt = nt;
    if constexpr (Sched::VARK) cnt = __builtin_amdgcn_readfirstlane(cur.nt);
    AccT acc[2][2][4][2];
#pragma unroll
    for (int a = 0; a < 2; ++a)
#pragma unroll
        for (int b = 0; b < 2; ++b)
#pragma unroll
            for (int m = 0; m < 4; ++m)
#pragma unroll
                for (int n = 0; n < 2; ++n) acc[a][b][m][n] = (AccT){0, 0, 0, 0};
    bf16x8 At[4][2], B0[2][2], B1[2][2];
    unsigned c00, c01, c10, c11, n00, n01, n10, n11;
    if constexpr (Sched::GATHER) {
        S.arow4_issue(cur, RA[0], RA[1], 128 + RA[0], 128 + RA[1], c00, c01, c10, c11); S.arow4_finish(cur, RA[0], RA[1], 128 + RA[0], 128 + RA[1], CA[0] * 2u, CA[1] * 2u, c00, c01, c10, c11);
    } else {
        c00 = (unsigned)(RA[0] * PB + CA[0] * 2); c01 = (unsigned)(RA[1] * PB + CA[1] * 2); c10 = c00 + (unsigned)hstep; c11 = c01 + (unsigned)hstep;
    }
    n00 = c00; n01 = c01; n10 = c10; n11 = c11;
    const char* cA = cur.A; const char* cB = cur.B;
    PG8_STAGE_B(PG8_SB(0, 0), cB); PG8_STAGE_B(PG8_SB(0, 1), cB + hstep); PG8_STAGE_A(PG8_SA(0, 0), cA, c00, c01); PG8_STAGE_A(PG8_SA(0, 1), cA, c10, c11);
    if (wr == 1) PG8_BAR;
    PG8_WAIT_V(2); PG8_BAR;
    PG8_STAGE_B(PG8_SB(1, 0), cB + kstep); PG8_STAGE_A(PG8_SA(1, 0), cA + kstep, c00, c01); PG8_STAGE_B(PG8_SB(1, 1), cB + hstep + kstep);
    PG8_WAIT_V(6); PG8_BAR;
    for (;;) {
        const bool has_next = S.next(ui + 1, nxt);
        const char* nA = has_next ? nxt.A : cA; const char* nB = has_next ? nxt.B : cB;
        E.stage(cur, lds + SCLZ_OFF + (ui & 1) * 2048, wid, lane);
        if constexpr (Sched::GATHER) {
            if (has_next) S.arow4_dma(nxt, RA[0], RA[1], 128 + RA[0], 128 + RA[1], lds + GROW_OFF + wid * 256);
        }
        for (int t = 0; t < cnt; t += 2) {
            const bool last = (t == cnt - 2);
            const char* a1 = cA + (size_t)(t + 1) * kstep;
            const char* a2 = last ? nA : cA + (size_t)(t + 2) * kstep; const char* b2 = last ? nB : cB + (size_t)(t + 2) * kstep;
            const char* a3 = a2 + kstep; const char* b3 = b2 + kstep;
            unsigned s00 = c00, s01 = c01, s10 = c10, s11 = c11;
            if constexpr (Sched::GATHER) {
                if (last && has_next) {
                    const volatile LAS unsigned* gr = (const volatile LAS unsigned*)(lds + GROW_OFF + wid * 256) + lane;
                    n00 = gr[0]; n01 = gr[512]; n10 = gr[1024]; n11 = gr[1536];
                    S.arow4_finish(nxt, RA[0], RA[1], 128 + RA[0], 128 + RA[1], CA[0] * 2u, CA[1] * 2u, n00, n01, n10, n11);
                }
                if (last) { s00 = n00; s01 = n01; s10 = n10; s11 = n11; }
            }
            PG8_LDB(B0, 0, 0); PG8_LDB(B1, 0, 1); PG8_SCHED; PG8_LDA(At, 0, 0); PG8_STAGE_A(PG8_SA(1, 1), a1, c10, c11);
            PG8_WAIT_V(8); PG8_WAIT_L(0); PG8_BAR; PG8_MMA(0, 0, At, B0); PG8_MMA(0, 1, At, B1); PG8_BAR; PG8_SCHED;
            PG8_LDA(At, 0, 1); PG8_STAGE_B(PG8_SB(0, 0), b2); PG8_STAGE_B(PG8_SB(0, 1), b2 + hstep); PG8_STAGE_A(PG8_SA(0, 0), a2, s00, s01);
            PG8_WAIT_V(8); PG8_WAIT_L(0); PG8_BAR; PG8_MMA(1, 0, At, B0); PG8_MMA(1, 1, At, B1); PG8_BAR; PG8_SCHED;
            PG8_LDB(B0, 1, 0); PG8_LDB(B1, 1, 1); PG8_SCHED; PG8_LDA(At, 1, 0); PG8_STAGE_A(PG8_SA(0, 1), a2, s10, s11);
            PG8_WAIT_V(8); PG8_WAIT_L(0); PG8_BAR; PG8_MMA(0, 0, At, B0); PG8_MMA(0, 1, At, B1); PG8_BAR; PG8_SCHED;
            PG8_LDA(At, 1, 1); PG8_STAGE_B(PG8_SB(1, 0), b3); PG8_STAGE_B(PG8_SB(1, 1), b3 + hstep); PG8_STAGE_A(PG8_SA(1, 0), a3, s00, s01);
            PG8_WAIT_V(8); PG8_WAIT_L(0); PG8_BAR; PG8_MMA(1, 0, At, B0); PG8_MMA(1, 1, At, B1); PG8_BAR; PG8_SCHED;
        }
        if constexpr (ALIGN_EPI) { if (wr == 0) PG8_BAR; }
        E(acc, cur, wr, wc, fr, fq, lds + SCLZ_OFF + (ui & 1) * 2048);
        if (!has_next) break;
#pragma unroll
        for (int a = 0; a < 2; ++a)
#pragma unroll
            for (int b = 0; b < 2; ++b)
#pragma unroll
                for (int m = 0; m < 4; ++m)
#pragma unroll
                    for (int n = 0; n < 2; ++n) acc[a][b][m][n] = (AccT){0, 0, 0, 0};
        cur = nxt; cA = nA; cB = nB; ++ui;
        if constexpr (Sched::VARK) cnt = __builtin_amdgcn_readfirstlane(cur.nt);
        c00 = n00; c01 = n01; c10 = n10; c11 = n11;
        if constexpr (ALIGN_EPI) { if (wr == 1) PG8_BAR; }
    }
    PG8_WAIT_V(0);
    if constexpr (!ALIGN_EPI) { if (wr == 0) PG8_BAR; }
    PG8_BAR;
#undef PG8_SA
#undef PG8_SB
#undef PG8_STAGE_A
#undef PG8_STAGE_B
#undef PG8_LDA
#undef PG8_LDB
#undef PG8_MMA
#undef PG8_WAIT_V
#undef PG8_WAIT_L
#undef PG8_BAR
#undef PG8_SCHED
}
}

struct SchedInproj {
    static constexpr bool GATHER = false, VARK = false;
    const char* H; const char* W; int G, c;
    template <bool UNI = true> __device__ __forceinline__ bool next(int i, pg8::Unit& u) const {
        const int L = i * G + c; if (L >= 2304 + 128) return false;
        int pm, pn;
        if (L < 2304) pg8::rect_order(L, 64, 36, pm, pn);
        else { const int idx = L - 2304, q = idx >> 3; pm = 64 + (idx & 7); pn = q < 4 ? q : q + 8; }
        u.pm = pm; u.pn = pn; u.e = 0; u.aux = 0; u.idx = i;
        u.A = H + (size_t)pm * 256 * D; u.B = W + (size_t)pn * 256 * D; return true;
    }
    __device__ __forceinline__ unsigned arow(const pg8::Unit&, int) const { return 0u; }
};
struct SchedSq {
    static constexpr bool GATHER = false, VARK = false;
    const char* A; const char* W; int G, c;
    __device__ __forceinline__ bool next(int i, pg8::Unit& u) const {
        const int L = i * G + c; if (L >= 256) return false;
        int pm, pn; pg8::rect_order(L, 64, 4, pm, pn);
        u.pm = pm; u.pn = pn; u.e = 0; u.aux = 0; u.idx = i;
        u.A = A + (size_t)pm * 256 * D * 2; u.B = W + (size_t)pn * 256 * D * 2; return true;
    }
    __device__ __forceinline__ unsigned arow(const pg8::Unit&, int) const { return 0u; }
};
template <int NT, bool GATH> struct SchedMoe {
    static constexpr bool GATHER = GATH, VARK = false;
    const char* A; const char* W; const int* list; volatile LAS int* tab; int G, c, pb;
    template <bool UNI = true> __device__ __forceinline__ bool next(int i, pg8::Unit& u) const {
        const int L = i * G + c; const int total = tab[32] * NT; if (L >= total) return false;
        int e = 0;
        if constexpr (UNI) {
            const int lj = (int)(threadIdx.x & 31);
            const unsigned long long bal = __ballot(tab[lj] * NT <= L);
            e = __builtin_popcount((unsigned)bal) - 1;
        } else {
#pragma unroll 1
            for (int j = 1; j < 32; ++j) if (L >= tab[j] * NT) e = j;
        }
        const int tp = tab[e], tiles = tab[e + 1] - tp, local = L - tp * NT;
        const int mt = local % tiles, nt = local / tiles;
        u.pm = mt; u.pn = nt; u.e = e; u.aux = (tp + mt) * 256; u.idx = i;
        u.A = GATH ? A : A + (size_t)u.aux * pb;
        u.B = W + ((size_t)e * (NT * 256) + (size_t)nt * 256) * pb; return true;
    }
    __device__ __forceinline__ unsigned arow(const pg8::Unit& u, int R) const {
        const int pos = u.pm * 256 + R, n = tab[64 + u.e];
        const int tok = pos < n ? list[u.e * TL + pos] : 0;
        return (unsigned)tok * (unsigned)pb;
    }
    __device__ __forceinline__ void arow4_issue(const pg8::Unit& u, int R0, int R1, int R2, int R3, unsigned& o0, unsigned& o1, unsigned& o2, unsigned& o3) const {
        const int n = tab[64 + u.e], p0 = u.pm * 256 + R0, p1 = u.pm * 256 + R1, p2 = u.pm * 256 + R2, p3 = u.pm * 256 + R3;
        const int* lp = list + (size_t)u.e * TL;
        o0 = (unsigned)lp[p0 < n ? p0 : 0]; o1 = (unsigned)lp[p1 < n ? p1 : 0]; o2 = (unsigned)lp[p2 < n ? p2 : 0]; o3 = (unsigned)lp[p3 < n ? p3 : 0];
    }
    __device__ __forceinline__ void arow4_dma(const pg8::Unit& u, int R0, int R1, int R2, int R3, LAS unsigned char* dst) const {
        const int n = tab[64 + u.e], p0 = u.pm * 256 + R0, p1 = u.pm * 256 + R1, p2 = u.pm * 256 + R2, p3 = u.pm * 256 + R3;
        const int* lp = list + (size_t)u.e * TL;
        __builtin_amdgcn_global_load_lds((const unsigned*)(lp + (p0 < n ? p0 : 0)), (LAS unsigned*)dst, 4, 0, 0);
        __builtin_amdgcn_global_load_lds((const unsigned*)(lp + (p1 < n ? p1 : 0)), (LAS unsigned*)(dst + 2048), 4, 0, 0);
        __builtin_amdgcn_global_load_lds((const unsigned*)(lp + (p2 < n ? p2 : 0)), (LAS unsigned*)(dst + 4096), 4, 0, 0);
        __builtin_amdgcn_global_load_lds((const unsigned*)(lp + (p3 < n ? p3 : 0)), (LAS unsigned*)(dst + 6144), 4, 0, 0);
    }
    __device__ __forceinline__ void arow4_finish(const pg8::Unit& u, int R0, int R1, int R2, int R3, unsigned c0, unsigned c1, unsigned& o0, unsigned& o1, unsigned& o2, unsigned& o3) const {
        const int n = tab[64 + u.e], p0 = u.pm * 256 + R0, p1 = u.pm * 256 + R1, p2 = u.pm * 256 + R2, p3 = u.pm * 256 + R3;
        o0 = (p0 < n ? o0 : 0u) * (unsigned)pb + c0; o1 = (p1 < n ? o1 : 0u) * (unsigned)pb + c1; o2 = (p2 < n ? o2 : 0u) * (unsigned)pb + c0; o3 = (p3 < n ? o3 : 0u) * (unsigned)pb + c1;
    }
};

struct SchedDown {
    static constexpr bool GATHER = false, VARK = true;
    const char* A; const char* W; volatile LAS int* tab; int G, c, pb;
    __device__ __forceinline__ void split(int& Lfull, int& nl, int& S) const { const int U = tab[32] * 4; Lfull = (U / G) * G; nl = U - Lfull; S = (nl > 0 && nl * 4 <= G) ? 4 : (nl > 0 && nl * 2 <= G) ? 2 : 1; }
    template <bool UNI = true> __device__ __forceinline__ bool next(int i, pg8::Unit& u) const {
        int Lfull, nl, S; split(Lfull, nl, S);
        int L = i * G + c, part = 0, lu = 0, knt = 16;
        if (L >= Lfull) { const int L2 = L - Lfull; if (L2 >= nl * S) return false;
            lu = L2 % nl; part = L2 / nl; L = Lfull + lu; knt = 16 / S; }
        const int lj = (int)(threadIdx.x & 31);
        const unsigned long long bal = __ballot(tab[lj] * 4 <= L);
        const int e = __builtin_popcount((unsigned)bal) - 1;
        const int tp = tab[e], tiles = tab[e + 1] - tp, local = L - tp * 4;
        const int mt = local % tiles, nt = local / tiles;
        u.pm = mt; u.pn = nt; u.e = e; u.aux = (tp + mt) * 256; u.idx = i; u.nt = knt; u.part = part; u.lu = lu;
        const size_t kofs = (size_t)part * (size_t)(knt * 128);
        u.A = A + (size_t)u.aux * pb + kofs;
        u.B = W + ((size_t)e * 1024 + (size_t)nt * 256) * pb + kofs; return true;
    }
    __device__ __forceinline__ unsigned arow(const pg8::Unit&, int) const { return 0u; }
    __device__ __forceinline__ void arow4_issue(const pg8::Unit&, int, int, int, int, unsigned&, unsigned&, unsigned&, unsigned&) const {}
    __device__ __forceinline__ void arow4_dma(const pg8::Unit&, int, int, int, int, LAS unsigned char*) const {}
    __device__ __forceinline__ void arow4_finish(const pg8::Unit&, int, int, int, int, unsigned, unsigned, unsigned&, unsigned&, unsigned&, unsigned&) const {}
};

constexpr int UCAP = 12, UC_ROWS = 131072, UC_REC = UC_ROWS + UCAP * 1024;
template <class Base, bool ROWS = true> struct SchedCached {
    static constexpr bool GATHER = Base::GATHER, VARK = false;
    Base base; LAS unsigned char* lds;
    __device__ __forceinline__ void init(int tid) {
        volatile LAS unsigned* rec = (volatile LAS unsigned*)(lds + UC_REC);
        if (tid < UCAP) { pg8::Unit u; const bool ok = base.template next<false>(tid, u);
            const unsigned long long a = (unsigned long long)u.A, b = (unsigned long long)u.B;
            rec[tid * 8 + 0] = ok ? (unsigned)a : 0u; rec[tid * 8 + 1] = ok ? (unsigned)(a >> 32) : 0u; rec[tid * 8 + 2] = ok ? (unsigned)b : 0u; rec[tid * 8 + 3] = ok ? (unsigned)(b >> 32) : 0u;
            rec[tid * 8 + 4] = ok ? ((unsigned)u.pm | ((unsigned)u.pn << 16)) : 0xffffffffu; rec[tid * 8 + 5] = (unsigned)u.e; rec[tid * 8 + 6] = (unsigned)u.aux; rec[tid * 8 + 7] = ok ? 1u : 0u; }
        __syncthreads();
        if constexpr (Base::GATHER && ROWS) {
            volatile LAS int* rows = (volatile LAS int*)(lds + UC_ROWS);
            for (int x = tid; x < UCAP * 256; x += NWAVES * 64) { const int i = x >> 8, r = x & 255;
                if (rec[i * 8 + 7]) { pg8::Unit u; u.pm = (int)(rec[i * 8 + 4] & 0xffffu); u.e = (int)rec[i * 8 + 5]; rows[x] = (int)base.arow(u, r); } }
            __syncthreads();
        }
    }
    __device__ __forceinline__ bool next(int i, pg8::Unit& u) const {
        if (i >= UCAP) { const bool ok = base.next(i, u); u.idx = i; return ok; }
        volatile LAS unsigned* rec = (volatile LAS unsigned*)(lds + UC_REC) + i * 8;
        if (!rec[7]) return false;
        u.A = (const char*)((unsigned long long)rec[0] | ((unsigned long long)rec[1] << 32)); u.B = (const char*)((unsigned long long)rec[2] | ((unsigned long long)rec[3] << 32));
        const unsigned pp = rec[4]; u.pm = (int)(pp & 0xffffu); u.pn = (int)(pp >> 16); u.e = (int)rec[5]; u.aux = (int)rec[6]; u.idx = i; return true;
    }
    __device__ __forceinline__ unsigned arow(const pg8::Unit& u, int R) const {
        if constexpr (Base::GATHER && ROWS) { if (u.idx < UCAP) return (unsigned)((volatile LAS int*)(lds + UC_ROWS))[u.idx * 256 + R]; }
        return base.arow(u, R);
    }
    __device__ __forceinline__ void arow4_issue(const pg8::Unit&, int, int, int, int, unsigned&, unsigned&, unsigned&, unsigned&) const {}
    __device__ __forceinline__ void arow4_dma(const pg8::Unit&, int, int, int, int, LAS unsigned char*) const {}
    __device__ __forceinline__ void arow4_finish(const pg8::Unit& u, int R0, int R1, int R2, int R3, unsigned c0, unsigned c1, unsigned& o0, unsigned& o1, unsigned& o2, unsigned& o3) const {
        o0 = arow(u, R0) + c0; o1 = arow(u, R1) + c1; o2 = arow(u, R2) + c0; o3 = arow(u, R3) + c1;
    }
};

struct EpiInproj {
    static constexpr bool PERM = true, HAS_MID = false;
    bf16* P; const float* hs; const float* ws;
    template <int ACT> __device__ __forceinline__ void body(const i32x4 (&acc)[2][2][4][2], bf16* rowbase, const float (&rsv)[2][4], const f32x4 (&wv)[2][2]) const {
#pragma unroll
        for (int ai = 0; ai < 2; ++ai)
#pragma unroll
            for (int m = 0; m < 4; ++m) { const float rs = rsv[ai][m]; bf16* rowp = rowbase + (size_t)(ai * 128 + m * 16) * D;
#pragma unroll
                for (int bj = 0; bj < 2; ++bj) { float o[8];
#pragma unroll
                    for (int q = 0; q < 8; ++q) { const float a = (float)acc[ai][bj][m][q >> 2][q & 3], sc = rs * wv[bj][q >> 2][q & 3];
                        if (ACT == 0) o[q] = a * sc;
                        else if (ACT == 3) o[q] = __builtin_amdgcn_rcpf(1.0f + __builtin_amdgcn_exp2f(a * (sc * -1.44269504089f)));
                        else if (ACT == 2) { const float x = a * sc; o[q] = x * __builtin_amdgcn_rcpf(1.0f + __builtin_amdgcn_exp2f(x * -1.44269504089f)); }
                        else { const float x = a * sc; const float u = __builtin_fmaf(x * x, -1.44269504089f * 0.0713548163f, -1.44269504089f * 1.5957691216f); o[q] = x * __builtin_amdgcn_rcpf(1.0f + __builtin_amdgcn_exp2f(x * u)); } }
                    u32x4 w; w.x = pkbf(o[0], o[1]); w.y = pkbf(o[2], o[3]); w.z = pkbf(o[4], o[5]); w.w = pkbf(o[6], o[7]);
                    __builtin_nontemporal_store(w, (u32x4*)(rowp + bj * 128)); } }
    }
    __device__ __forceinline__ void stage(const pg8::Unit& u, LAS unsigned char* z, int wid, int lane) const {
        if (wid == 0) __builtin_amdgcn_global_load_lds((const unsigned*)(hs + u.pm * 256 + 4 * lane), (LAS unsigned*)z, 16, 0, 0);
        if (wid == 1) __builtin_amdgcn_global_load_lds((const unsigned*)(ws + u.pn * 256 + 4 * lane), (LAS unsigned*)(z + 1024), 16, 0, 0);
    }
    __device__ __forceinline__ void operator()(const i32x4 (&acc)[2][2][4][2], const pg8::Unit& u, int wr, int wc, int fr, int fq, const LAS unsigned char* z) const {
        const int pn = __builtin_amdgcn_readfirstlane(u.pn), pm = __builtin_amdgcn_readfirstlane(u.pm);
        const int grp = pn >> 2, colt = (pn & 3) * 256;
        const int row0 = pm * 256 + wr * 64 + fr, col0 = colt + wc * 32 + 8 * fq;
        const int mode = (grp == 1) ? 1 : (grp == 2 || grp == 6) ? 2 : (grp >= 7) ? 3 : 0;
        f32x4 wv[2][2]; float rsv[2][4];
        const LAS float* zr = (const LAS float*)z + wr * 64 + fr; const LAS float* zc = (const LAS float*)(z + 1024) + wc * 32 + 8 * fq;
#pragma unroll
        for (int bj = 0; bj < 2; ++bj)
#pragma unroll
            for (int n = 0; n < 2; ++n) wv[bj][n] = *(const LAS f32x4*)(zc + bj * 128 + 4 * n);
#pragma unroll
        for (int ai = 0; ai < 2; ++ai)
#pragma unroll
            for (int m = 0; m < 4; ++m) rsv[ai][m] = zr[ai * 128 + m * 16];
        bf16* rowbase = P + (size_t)grp * PG_STRIDE + (size_t)row0 * D + col0;
        if (mode == 0) body<0>(acc, rowbase, rsv, wv);
        else if (mode == 3) body<3>(acc, rowbase, rsv, wv);
        else if (mode == 2) body<2>(acc, rowbase, rsv, wv);
        else body<1>(acc, rowbase, rsv, wv);
    }
};
template <int MODE> struct EpiMerge {
    static constexpr bool PERM = true;
    bf16* O; const bf16* gate; const bf16* prev;
    __device__ __forceinline__ void stage(const pg8::Unit&, LAS unsigned char*, int, int) const {}
    __device__ __forceinline__ void operator()(const f32x4 (&acc)[2][2][4][2], const pg8::Unit& u, int wr, int wc, int fr, int fq, const LAS unsigned char*) const {
        const int row0 = u.pm * 256 + wr * 64 + fr, col0 = u.pn * 256 + wc * 32 + 8 * fq;
        const size_t off0 = (size_t)row0 * D + col0;
        u32x4 g[2][4][2], p[MODE == 1 ? 2 : 1][4][2], w[2][4][2];
#define EM_LOAD(ai) do { _Pragma("unroll") for (int m = 0; m < 4; ++m) _Pragma("unroll") for (int bj = 0; bj < 2; ++bj) { const size_t off = off0 + (size_t)((ai) * 128 + m * 16) * D + bj * 128; \
            g[ai][m][bj] = *(const u32x4*)(gate + off); if (MODE == 1) p[MODE == 1 ? (ai) : 0][m][bj] = *(const u32x4*)(prev + off); } } while (0)
#define EM_CALC(ai) do { _Pragma("unroll") for (int m = 0; m < 4; ++m) _Pragma("unroll") for (int bj = 0; bj < 2; ++bj) { const u32x4 gg = g[ai][m][bj]; float o[8]; const f32x4 v0 = acc[ai][bj][m][0], v1 = acc[ai][bj][m][1]; \
            o[0] = v0[0] * bflo(gg.x); o[1] = v0[1] * bfhi(gg.x); o[2] = v0[2] * bflo(gg.y); o[3] = v0[3] * bfhi(gg.y); o[4] = v1[0] * bflo(gg.z); o[5] = v1[1] * bfhi(gg.z); o[6] = v1[2] * bflo(gg.w); o[7] = v1[3] * bfhi(gg.w); \
            if (MODE == 1) { const u32x4 pp = p[MODE == 1 ? (ai) : 0][m][bj]; o[0] += bflo(pp.x); o[1] += bfhi(pp.x); o[2] += bflo(pp.y); o[3] += bfhi(pp.y); o[4] += bflo(pp.z); o[5] += bfhi(pp.z); o[6] += bflo(pp.w); o[7] += bfhi(pp.w); } \
            w[ai][m][bj] = (u32x4){pkbf(o[0], o[1]), pkbf(o[2], o[3]), pkbf(o[4], o[5]), pkbf(o[6], o[7])}; } } while (0)
#define EM_STORE(ai) do { _Pragma("unroll") for (int m = 0; m < 4; ++m) _Pragma("unroll") for (int bj = 0; bj < 2; ++bj) *(u32x4*)(O + off0 + (size_t)((ai) * 128 + m * 16) * D + bj * 128) = w[ai][m][bj]; } while (0)
        EM_LOAD(0); __builtin_amdgcn_sched_barrier(0); EM_CALC(0); __builtin_amdgcn_sched_barrier(0);
        EM_LOAD(1); __builtin_amdgcn_sched_barrier(0); EM_STORE(0); __builtin_amdgcn_sched_barrier(0);
        EM_CALC(1); EM_STORE(1);
#undef EM_LOAD
#undef EM_CALC
#undef EM_STORE
    }
};
struct EpiX1 {
    static constexpr bool PERM = true;
    bf16* X1; const float* x; const float* mod;
    __device__ __forceinline__ void stage(const pg8::Unit&, LAS unsigned char*, int, int) const {}
    __device__ __forceinline__ void operator()(const f32x4 (&acc)[2][2][4][2], const pg8::Unit& u, int wr, int wc, int fr, int fq, const LAS unsigned char*) const {
        const int row0 = u.pm * 256 + wr * 64 + fr, col0 = u.pn * 256 + wc * 32 + 8 * fq;
        const float* mg = mod + (size_t)(u.pm >> 3) * NMOD + 2 * D;
        f32x4 gv[2][2];
#pragma unroll
        for (int bj = 0; bj < 2; ++bj)
#pragma unroll
            for (int n = 0; n < 2; ++n) gv[bj][n] = *(const f32x4*)(mg + col0 + bj * 128 + 4 * n);
        const size_t off0 = (size_t)row0 * D + col0;
        f32x4 xv[2][4][2][2];
#define EX_LOAD(ai) do { _Pragma("unroll") for (int m = 0; m < 4; ++m) _Pragma("unroll") for (int bj = 0; bj < 2; ++bj) _Pragma("unroll") for (int n = 0; n < 2; ++n) \
            xv[ai][m][bj][n] = *(const f32x4*)(x + off0 + (size_t)((ai) * 128 + m * 16) * D + bj * 128 + 4 * n); } while (0)
#define EX_CALC(ai) do { _Pragma("unroll") for (int m = 0; m < 4; ++m) _Pragma("unroll") for (int bj = 0; bj < 2; ++bj) _Pragma("unroll") for (int n = 0; n < 2; ++n) \
            xv[ai][m][bj][n] = xv[ai][m][bj][n] + gv[bj][n] * acc[ai][bj][m][n]; } while (0)
#define EX_STORE(ai) do { _Pragma("unroll") for (int m = 0; m < 4; ++m) _Pragma("unroll") for (int bj = 0; bj < 2; ++bj) { const f32x4 v0 = xv[ai][m][bj][0], v1 = xv[ai][m][bj][1]; \
            *(u32x4*)(X1 + off0 + (size_t)((ai) * 128 + m * 16) * D + bj * 128) = (u32x4){pkbf(v0[0], v0[1]), pkbf(v0[2], v0[3]), pkbf(v1[0], v1[1]), pkbf(v1[2], v1[3])}; } } while (0)
        EX_LOAD(0); __builtin_amdgcn_sched_barrier(0); EX_CALC(0); __builtin_amdgcn_sched_barrier(0);
        EX_LOAD(1); __builtin_amdgcn_sched_barrier(0); EX_STORE(0); __builtin_amdgcn_sched_barrier(0);
        EX_CALC(1); EX_STORE(1);
#undef EX_LOAD
#undef EX_CALC
#undef EX_STORE
    }
};
struct EpiAct {
    static constexpr bool PERM = true, HAS_MID = false;
    bf16* ACT; const float* b1; const float* scl; const float* sw1;
    __device__ __forceinline__ void stage(const pg8::Unit& u, LAS unsigned char* z, int wid, int lane) const {
        if (wid == 0) __builtin_amdgcn_global_load_lds((const unsigned*)(scl + (size_t)u.e * TL + u.pm * 256 + 4 * lane), (LAS unsigned*)z, 16, 0, 0);
        if (wid == 1) __builtin_amdgcn_global_load_lds((const unsigned*)(b1 + (size_t)u.e * 2048 + u.pn * 256 + 4 * lane), (LAS unsigned*)(z + 1024), 16, 0, 0);
    }
    __device__ __forceinline__ void operator()(const i32x4 (&acc)[2][2][4][2], const pg8::Unit& u, int wr, int wc, int fr, int fq, const LAS unsigned char* z) const {
        const int row0 = u.aux + wr * 64 + fr;
        const int vc0 = u.pn * 256 + wc * 32 + 8 * fq;
        const float sw = sw1[u.e];
        float rs[2][4]; f32x4 ba[2], bbv[2];
        const LAS float* zr = (const LAS float*)z + wr * 64 + fr; const LAS float* zc = (const LAS float*)(z + 1024) + wc * 32 + 8 * fq;
#pragma unroll
        for (int ai = 0; ai < 2; ++ai)
#pragma unroll
            for (int m = 0; m < 4; ++m) rs[ai][m] = zr[ai * 128 + m * 16];
#pragma unroll
        for (int bj = 0; bj < 2; ++bj) { ba[bj] = *(const LAS f32x4*)(zc + bj * 128); bbv[bj] = *(const LAS f32x4*)(zc + bj * 128 + 4); }
#pragma unroll
        for (int ai = 0; ai < 2; ++ai)
#pragma unroll
            for (int m = 0; m < 4; ++m) rs[ai][m] *= sw;
#pragma unroll
        for (int bj = 0; bj < 2; ++bj) {
            const int vc = vc0 + bj * 128, j0 = vc >> 1;
            const float bg[4] = {ba[bj][0], ba[bj][2], bbv[bj][0], bbv[bj][2]}, bu[4] = {ba[bj][1] + 1.0f, ba[bj][3] + 1.0f, bbv[bj][1] + 1.0f, bbv[bj][3] + 1.0f};
#pragma unroll
            for (int ai = 0; ai < 2; ++ai)
#pragma unroll
                for (int m = 0; m < 4; ++m) { float o[4];
#pragma unroll
                    for (int q = 0; q < 4; ++q) { float hg = (float)acc[ai][bj][m][0][q] * rs[ai][m] + bg[q], hu = (float)acc[ai][bj][m][1][q] * rs[ai][m] + bu[q];
                        hg = fminf(hg, 7.0f); hu = fminf(fmaxf(hu, -6.0f), 8.0f);
                        o[q] = hg * __builtin_amdgcn_rcpf(1.0f + __builtin_amdgcn_exp2f(hg * -2.4554669596f)) * hu; }
                    u32x2 w; w.x = pkbf(o[0], o[1]); w.y = pkbf(o[2], o[3]);
                    *(u32x2*)(ACT + (size_t)(row0 + ai * 128 + m * 16) * D + j0) = w; }
        }
    }
};
struct EpiY {
    static constexpr bool PERM = true;
    bf16* Y; const float* b2; bf16* YP;
    __device__ __forceinline__ void stage(const pg8::Unit& u, LAS unsigned char* z, int wid, int lane) const {
        if (wid == 1) __builtin_amdgcn_global_load_lds((const unsigned*)(b2 + (size_t)u.e * D + u.pn * 256 + 4 * lane), (LAS unsigned*)(z + 1024), 16, 0, 0);
    }
    __device__ __forceinline__ void operator()(const f32x4 (&acc)[2][2][4][2], const pg8::Unit& u, int wr, int wc, int fr, int fq, const LAS unsigned char* z) const {
        const int part = __builtin_amdgcn_readfirstlane(u.part);
        bf16* tile = part == 0 ? Y + (size_t)u.aux * D + u.pn * 256 : YP + (size_t)((part - 1) * 256 + u.lu) * 65536;
        const int pitch = part == 0 ? D : 256;
        const float bsc = part == 0 ? 1.0f : 0.0f;
        const LAS float* zc = (const LAS float*)(z + 1024) + wc * 32 + 8 * fq;
        f32x4 bv[2][2];
#pragma unroll
        for (int bj = 0; bj < 2; ++bj)
#pragma unroll
            for (int n = 0; n < 2; ++n) bv[bj][n] = *(const LAS f32x4*)(zc + bj * 128 + 4 * n) * bsc;
#pragma unroll
        for (int ai = 0; ai < 2; ++ai)
#pragma unroll
            for (int m = 0; m < 4; ++m) { bf16* rowp = tile + (size_t)(wr * 64 + fr + ai * 128 + m * 16) * pitch + wc * 32 + 8 * fq;
#pragma unroll
                for (int bj = 0; bj < 2; ++bj) { const f32x4 v0 = acc[ai][bj][m][0] + bv[bj][0], v1 = acc[ai][bj][m][1] + bv[bj][1];
                    u32x4 w; w.x = pkbf(v0[0], v0[1]); w.y = pkbf(v0[2], v0[3]); w.z = pkbf(v1[0], v1[1]); w.w = pkbf(v1[2], v1[3]);
                    *(u32x4*)(rowp + bj * 128) = w; } }
    }
};

struct Args { const float* in[28]; float* out; unsigned char* ws; int ph_lo, ph_hi; };
struct Frame {
    LAS unsigned char* lds; int tid, lane, wave, G, vcu; unsigned char* ws; const float* const* in; float* out;
};
enum { I_X = 0, I_C, I_CTX, I_CCTX, I_ADAW, I_ADAB, I_N1G, I_N2G, I_WIN, I_CONVW, I_CONVB, I_WA, I_BA, I_WX, I_BX, I_LAM, I_LBL, I_HGG, I_WBA, I_WBB, I_WOUT,
       I_RW, I_RB, I_W1, I_B1, I_W2, I_B2, I_FG };

__device__ __forceinline__ void transpose_item(const float* W, int K, int N, bf16* WT, int row_off, LAS float* scr, int item, int lane, bool swz) {
    const int nblk = N / 32, kb = item / nblk, nb = item % nblk, k0 = 64 * kb, n0 = 32 * nb;
    float tv[32];
#pragma unroll
    for (int i = 0; i < 32; ++i) { const int kk = 2 * i + (lane >> 5); tv[i] = W[(size_t)(k0 + kk) * N + n0 + (lane & 31)]; }
#pragma unroll
    for (int i = 0; i < 32; ++i) { const int kk = 2 * i + (lane >> 5); scr[kk * 33 + (lane & 31)] = tv[i]; }
    LDS_WAIT(); asm volatile("" ::: "memory");
    const int c = lane & 7;
#pragma unroll
    for (int j = 0; j < 4; ++j) { const int n = (lane >> 3) + 8 * j; const LAS float* s = scr + (8 * c) * 33 + n;
        u32x4 o; o.x = pk2(s[0 * 33], s[1 * 33]); o.y = pk2(s[2 * 33], s[3 * 33]); o.z = pk2(s[4 * 33], s[5 * 33]); o.w = pk2(s[6 * 33], s[7 * 33]);
        const int x = n & 7, nv = swz ? ((n & ~7) + ((x & 1) * 4 + (x >> 1))) : n;
        *(u32x4*)(WT + (size_t)(row_off + n0 + nv) * K + k0 + 8 * c) = o; }
    LDS_WAIT(); asm volatile("" ::: "memory");
}
constexpr int MOE_ITEMS = 32 * 32 * 64 + 32 * 32 * 32;
#ifndef HG_FILL_CH
#define HG_FILL_CH 36
#endif
#ifndef P10T_N
#define P10T_N 12288
#endif
constexpr int P10T_LO = HG_FILL_CH * 2048, P10T_HI = P10T_LO + P10T_N, P2F_LO = P10T_HI;
static_assert(P10T_LO >= 65536 && P10T_HI <= MOE_ITEMS, "only w2 items may be left to the up-projection's tail");
struct MoeItem { const float* W; bf16* WT; int N, k0, n0; bool swz; float inv; };
template <bool LOAD_INV = true> __device__ __forceinline__ MoeItem moe_item(const Frame& F, int item) {
    MoeItem m;
    if (item < 65536) { const int e = item >> 11, sub = item & 2047, kb = sub >> 6, nb = sub & 63;
        m.W = F.in[I_W1] + (size_t)e * D * 2048; m.WT = (bf16*)(F.ws + WS_W1 + (size_t)e * 2048 * D); m.N = 2048; m.k0 = kb * 32; m.n0 = nb * 32; m.swz = true; m.inv = LOAD_INV ? ((const float*)(F.ws + WS_SW1))[32 + e] : 1.0f; }
    else { const int r = item - 65536, e = r >> 10, sub = r & 1023, kb = sub >> 5, nb = sub & 31;
        m.W = F.in[I_W2] + (size_t)e * D * D; m.WT = (bf16*)(F.ws + WS_W2) + (size_t)e * D * D; m.N = D; m.k0 = kb * 32; m.n0 = nb * 32; m.swz = false; m.inv = 1.0f; }
    return m;
}
__device__ __forceinline__ void moe_conv_issue(const MoeItem& m, int lane, float (&tv)[16]) {
#pragma unroll
    for (int i = 0; i < 16; ++i) tv[i] = m.W[(size_t)(m.k0 + 2 * i + (lane >> 5)) * m.N + m.n0 + (lane & 31)];
}
__device__ __forceinline__ void moe_conv_finish(const MoeItem& m, int lane, const float (&tv)[16], LAS float* scr) {
#pragma unroll
    for (int i = 0; i < 16; ++i) scr[(2 * i + (lane >> 5)) * 33 + (lane & 31)] = tv[i];
    asm volatile("" ::: "memory");
    const int n = lane >> 1, hk = (lane & 1) * 16;
    const int x = n & 7, nv = m.swz ? ((n & ~7) + ((x & 1) * 4 + (x >> 1))) : n;
    if (m.swz) {
        unsigned o[4];
#pragma unroll
        for (int j = 0; j < 4; ++j) { unsigned wv = 0u;
            unsigned t[4];
#pragma unroll
            for (int b = 0; b < 4; ++b) t[b] = __float_as_uint(__builtin_amdgcn_fmed3f(__builtin_fmaf(scr[(hk + 4 * j + b) * 33 + n], m.inv, 12582912.0f), 12582912.0f - 127.0f, 12582912.0f + 127.0f));
            wv = __builtin_amdgcn_perm(__builtin_amdgcn_perm(t[3], t[2], 0x0c0c0400u), __builtin_amdgcn_perm(t[1], t[0], 0x0c0c0400u), 0x05040100u);
            o[j] = wv; }
        unsigned char* dst = (unsigned char*)m.WT + (size_t)(m.n0 + nv) * D + m.k0 + hk;
        *(u32x4*)dst = (u32x4){o[0], o[1], o[2], o[3]};
    } else {
        unsigned o[8];
#pragma unroll
        for (int j = 0; j < 8; ++j) o[j] = pkbf(scr[(hk + 2 * j) * 33 + n], scr[(hk + 2 * j + 1) * 33 + n]);
        bf16* dst = m.WT + (size_t)(m.n0 + nv) * D + m.k0 + hk;
        *(u32x4*)dst = (u32x4){o[0], o[1], o[2], o[3]}; *(u32x4*)(dst + 8) = (u32x4){o[4], o[5], o[6], o[7]};
    }
    asm volatile("" ::: "memory");
}
__device__ __forceinline__ void moe_dma_issue(const MoeItem& m, int lane, LAS unsigned char* scr) {
#pragma unroll
    for (int j = 0; j < 4; ++j) { const int q = j * 64 + lane, r = q >> 3, c = (q & 7) ^ (r & 7);
        __builtin_amdgcn_global_load_lds((const unsigned*)(m.W + (size_t)(m.k0 + r) * m.N + m.n0 + 4 * c), (LAS unsigned*)(scr + j * 1024), 16, 0, 0); }
}
__device__ __forceinline__ void moe_dma_finish(const MoeItem& m, int lane, const LAS unsigned char* scr) {
    const int n = lane >> 1, hk = (lane & 1) * 16;
    const int x = n & 7, nv = m.swz ? ((n & ~7) + ((x & 1) * 4 + (x >> 1))) : n;
    float v[16];
#pragma unroll
    for (int i = 0; i < 16; ++i) { const int r = hk + i; v[i] = *(const LAS float*)(scr + r * 128 + (((n >> 2) ^ (r & 7)) * 16) + (n & 3) * 4); }
    if (m.swz) {
        unsigned o[4];
#pragma unroll
        for (int j = 0; j < 4; ++j) { unsigned wv = 0u;
            unsigned t[4];
#pragma unroll
            for (int b = 0; b < 4; ++b) t[b] = __float_as_uint(__builtin_amdgcn_fmed3f(__builtin_fmaf(v[4 * j + b], m.inv, 12582912.0f), 12582912.0f - 127.0f, 12582912.0f + 127.0f));
            wv = __builtin_amdgcn_perm(__builtin_amdgcn_perm(t[3], t[2], 0x0c0c0400u), __builtin_amdgcn_perm(t[1], t[0], 0x0c0c0400u), 0x05040100u);
            o[j] = wv; }
        unsigned char* dst = (unsigned char*)m.WT + (size_t)(m.n0 + nv) * D + m.k0 + hk;
        *(u32x4*)dst = (u32x4){o[0], o[1], o[2], o[3]};
    } else {
        unsigned o[8];
#pragma unroll
        for (int j = 0; j < 8; ++j) o[j] = pkbf(v[2 * j], v[2 * j + 1]);
        bf16* dst = m.WT + (size_t)(m.n0 + nv) * D + m.k0 + hk;
        *(u32x4*)dst = (u32x4){o[0], o[1], o[2], o[3]}; *(u32x4*)(dst + 8) = (u32x4){o[4], o[5], o[6], o[7]};
    }
}
__device__ __forceinline__ void moe_fill_dma(const Frame& F, int first, int stride, int end) {
    LAS unsigned char* scr = F.lds + F.wave * 16384;
    const int lane = F.lane;
    const int n = first < end ? (end - first + stride - 1) / stride : 0;
#pragma unroll 1
    for (int k = 0; k < 3 && k < n; ++k) moe_dma_issue(moe_item(F, first + k * stride), lane, scr + (k & 3) * 4096);
#pragma unroll 1
    for (int k = 0; k < n; ++k) {
        const bool more = k + 3 < n;
        if (more) moe_dma_issue(moe_item(F, first + (k + 3) * stride), lane, scr + ((k + 3) & 3) * 4096);
        if (more && k >= 3) asm volatile("s_waitcnt vmcnt(15)" ::: "memory");
        else if (more) asm volatile("s_waitcnt vmcnt(12)" ::: "memory");
        else asm volatile("s_waitcnt vmcnt(0)" ::: "memory");
        moe_dma_finish(moe_item(F, first + k * stride), lane, scr + (k & 3) * 4096);
    }
}
__device__ __forceinline__ void p0_prologue(const Frame& F) {
    {
        LAS float* sc = (LAS float*)F.lds;
        LAS float* red = (LAS float*)(F.lds + 40960);
        bool loaded = false;
        for (int item = blockIdx.x; item < NMOD / 32; item += F.G) {
            if (!loaded) {
                for (int i = F.tid; i < 9 * D; i += 512) { const int v = i >> 10, k = i & 1023; const float cvv = v < 8 ? F.in[I_C][v * D + k] : F.in[I_CCTX][k];
                    sc[i] = cvv / (1.0f + __expf(-cvv)); }
                loaded = true; __syncthreads();
            }
            const int col = F.tid & 31, kg = F.tid >> 5, n0 = item * 32;
            float a[9];
#pragma unroll
            for (int v = 0; v < 9; ++v) a[v] = 0.f;
            const float* wp = F.in[I_ADAW] + n0 + col;
            float wv[64];
#pragma unroll
            for (int kk = 0; kk < 64; ++kk) wv[kk] = wp[(size_t)(kg + 16 * kk) * NMOD];
#pragma unroll
            for (int kk = 0; kk < 64; ++kk) { const int k = kg + 16 * kk; const float w = wv[kk];
#pragma unroll
                for (int v = 0; v < 9; ++v) a[v] += sc[v * D + k] * w; }
#pragma unroll
            for (int v = 0; v < 9; ++v) red[(kg * 9 + v) * 32 + col] = a[v];
            __syncthreads();
            if (F.tid < 288) { const int v = F.tid >> 5, cc = F.tid & 31; float s = 0.f;
#pragma unroll
                for (int g = 0; g < 16; ++g) s += red[(g * 9 + v) * 32 + cc];
                ((float*)(F.ws + WS_MOD))[(size_t)v * NMOD + n0 + cc] = s + F.in[I_ADAB][n0 + cc]; }
            __syncthreads();
        }
        __syncthreads();
    }
    if (blockIdx.x == F.G - 1) { for (int i = F.tid; i < 2 * D; i += 512) { const float nl = -F.in[I_LAM][i]; ((float*)(F.ws + WS_SPL))[i] = 1.44269504089f * 8.0f * (fmaxf(nl, 0.f) + log1pf(expf(-fabsf(nl)))); } }
    const bool deal256 = (F.G == 256);
    const int sx = deal256 ? (int)blockIdx.x - 192 : (int)blockIdx.x;
    if (sx >= 0 && sx < 32) {
        LAS float* RD = (LAS float*)(F.lds + 65536);
        const float* W = F.in[I_W1] + (size_t)sx * D * 2048;
        float mx = 0.f;
#pragma unroll
        for (int i = 0; i < 16; ++i) { const f32x4 v = *(const f32x4*)(W + (size_t)i * 2048 + 4 * F.tid); mx = fmaxf(mx, fmaxf(fmaxf(fabsf(v[0]), fabsf(v[1])), fmaxf(fabsf(v[2]), fabsf(v[3])))); }
#pragma unroll
        for (int o = 1; o < 64; o <<= 1) mx = fmaxf(mx, __shfl_xor(mx, o));
        if (F.lane == 0) RD[F.wave] = mx;
        __syncthreads();
        if (F.tid == 0) { float m8 = 0.f; for (int w8 = 0; w8 < 8; ++w8) m8 = fmaxf(m8, RD[w8]); const float sc = m8 > 0.f ? 1.3f * m8 * (1.0f / 127.0f) : 1.0f; ((float*)(F.ws + WS_SW1))[sx] = sc; ((float*)(F.ws + WS_SW1))[32 + sx] = 1.0f / sc; }
        __syncthreads();
    }
    {
        LAS float* CM = (LAS float*)(F.lds + 65536);
        LAS unsigned char* T8 = F.lds + 66560 + F.wave * 4224;
        const float* W = F.in[I_WIN]; unsigned char* WT = F.ws + WS_WIN; float* WSC = (float*)(F.ws + WS_WINS);
        for (int slab = blockIdx.x; slab < 288; slab = deal256 ? (slab < 256 && (int)blockIdx.x >= 224 ? 256 + (int)blockIdx.x - 224 : 288) : slab + F.G) {
            const int n0 = slab * 32, col = F.lane & 31, hi = F.lane >> 5, k0 = 128 * F.wave;
            float tv[64]; float mx = 0.f;
#pragma unroll
            for (int i = 0; i < 64; ++i) { tv[i] = W[(size_t)(k0 + 2 * i + hi) * (9 * D) + n0 + col]; }
#pragma unroll
            for (int i = 0; i < 64; ++i) mx = fmaxf(mx, fabsf(tv[i]));
            mx = fmaxf(mx, __shfl_xor(mx, 32));
            if (hi == 0) CM[F.wave * 32 + col] = mx;
            __syncthreads();
            float cmx = 0.f;
#pragma unroll
            for (int w8 = 0; w8 < 8; ++w8) cmx = fmaxf(cmx, CM[w8 * 32 + col]);
            const float sc = cmx > 0.f ? cmx * (1.0f / 127.0f) : 1.0f, inv = 1.0f / sc;
            if (F.wave == 0 && hi == 0) WSC[n0 + col] = sc;
#pragma unroll
            for (int i = 0; i < 64; ++i) T8[col * 132 + 2 * i + hi] = (unsigned char)((int)rintf(tv[i] * inv) & 255);
            LDS_WAIT(); asm volatile("" ::: "memory");
#pragma unroll
            for (int j = 0; j < 4; ++j) { const int ch = F.lane + 64 * j, n = ch >> 3, c16 = ch & 7;
                const LAS unsigned* sp = (const LAS unsigned*)(T8 + n * 132 + c16 * 16);
                *(u32x4*)(WT + (size_t)(n0 + n) * D + k0 + c16 * 16) = (u32x4){sp[0], sp[1], sp[2], sp[3]}; }
            __syncthreads();
        }
    }
    LAS float* scr = (LAS float*)(F.lds + F.wave * 16384);
    const int gw = F.vcu * NWAVES + F.wave, NGW = F.G * NWAVES;
    constexpr int I_SQ = 16 * 32, I_LRU = 32 * 8;
    constexpr int NITEMS = 3 * I_SQ + I_LRU;
    for (int it = gw; it < NITEMS; it += NGW) {
        int r = it;
        if (r < I_SQ) { transpose_item(F.in[I_WBA], D, D, (bf16*)(F.ws + WS_WBA), 0, scr, r, F.lane, false); continue; } r -= I_SQ;
        if (r < I_SQ) { transpose_item(F.in[I_WBB], D, D, (bf16*)(F.ws + WS_WBB), 0, scr, r, F.lane, false); continue; } r -= I_SQ;
        if (r < I_SQ) { transpose_item(F.in[I_WOUT], D, D, (bf16*)(F.ws + WS_WOUT), 0, scr, r, F.lane, false); continue; } r -= I_SQ;
        { const int mat = r >> 3, sub = r & 7, z = mat >> 4, dg = mat & 15, d = dg >> 3, g = dg & 7;
            transpose_item(F.in[z ? I_WX : I_WA] + (size_t)dg * 16384, 128, 128, (bf16*)(F.ws + WS_LRUW) + (size_t)((d * 2 + z) * 8 + g) * 16384, 0, scr, sub, F.lane, false); }
    }
}

__device__ __forceinline__ void p1_norm(const Frame& F) {
    const int gw = F.vcu * NWAVES + F.wave, NGW = F.G * NWAVES;
    const float* g1 = F.in[I_N1G]; const float* mod = (const float*)(F.ws + WS_MOD);
    unsigned char* H = F.ws + WS_H; float* HS = (float*)(F.ws + WS_HS);
    for (int rb = gw; rb < TT; rb += 3 * NGW) {
        int rr[3]; bool ok[3];
#pragma unroll
        for (int u = 0; u < 3; ++u) { ok[u] = rb + u * NGW < TT; rr[u] = ok[u] ? rb + u * NGW : rb; }
        f32x4 v[3][4];
#pragma unroll
        for (int u = 0; u < 3; ++u) { const int r = rr[u]; const float* src = r < TL ? F.in[I_X] + (size_t)r * D : F.in[I_CTX] + (size_t)(r - TL) * D;
#pragma unroll
            for (int j = 0; j < 4; ++j) v[u][j] = *(const f32x4*)(src + 4 * F.lane + 256 * j); }
#pragma unroll
        for (int u = 0; u < 3; ++u) {
            const int r = rr[u];
            const float* mv = mod + (size_t)(r < TL ? (r >> 11) : 8) * NMOD;
            float ss = 0.f;
#pragma unroll
            for (int j = 0; j < 4; ++j) ss += (v[u][j][0] * v[u][j][0] + v[u][j][1] * v[u][j][1]) + (v[u][j][2] * v[u][j][2] + v[u][j][3] * v[u][j][3]);
            const float rstd = 1.0f / sqrtf(wave_sum(ss) * (1.0f / D) + EPS);
            float amax = 0.f;
#pragma unroll
            for (int j = 0; j < 4; ++j) { const int c = 4 * F.lane + 256 * j;
                const f32x4 g = *(const f32x4*)(g1 + c), sh = *(const f32x4*)(mv + c), scl = *(const f32x4*)(mv + D + c);
                v[u][j] = v[u][j] * rstd * g * (scl + 1.0f) + sh;
                amax = fmaxf(amax, fmaxf(fmaxf(fabsf(v[u][j][0]), fabsf(v[u][j][1])), fmaxf(fabsf(v[u][j][2]), fabsf(v[u][j][3])))); }
#pragma unroll
            for (int o = 1; o < 64; o <<= 1) amax = fmaxf(amax, __shfl_xor(amax, o));
            const float sc = amax > 0.f ? amax * (1.0f / 127.0f) : 1.0f, inv = 1.0f / sc;
            if (ok[u]) {
#pragma unroll
                for (int j = 0; j < 4; ++j) { const int c = 4 * F.lane + 256 * j;
                    const int q0 = (int)rintf(v[u][j][0] * inv), q1 = (int)rintf(v[u][j][1] * inv), q2 = (int)rintf(v[u][j][2] * inv), q3 = (int)rintf(v[u][j][3] * inv);
                    *(unsigned*)(H + (size_t)r * D + c) = (unsigned)(q0 & 255) | ((unsigned)(q1 & 255) << 8) | ((unsigned)(q2 & 255) << 16) | ((unsigned)(q3 & 255) << 24); }
                if (F.lane == 0) HS[r] = sc; }
        }
    }
}

constexpr int LRU_U_OFF = 131072, LRU_U_STRIDE = 272, LRU_CW_OFF = 151552;
__device__ __forceinline__ void lru_pass1(const Frame& F, int widx, int nw) {
    const bf16* PAX = (const bf16*)(F.ws + WS_P);
    const bf16* LW = (const bf16*)(F.ws + WS_LRUW);
    float* AGG = (float*)(F.ws + WS_AGG);
    LAS float* AF = (LAS float*)F.lds;
    LAS unsigned char* UL = F.lds + LRU_U_OFF;
    LAS float* CWL = (LAS float*)(F.lds + LRU_CW_OFF);
    const int fr = F.lane & 15, fq = F.lane >> 4, w = F.wave;
    const int c8 = (F.tid & 15) * 8, pr = F.tid >> 4;
    for (int vw = widx; vw < 256; vw += nw) {
        const int g = vw & 7, b = (vw >> 3) & 7, q = vw >> 6;
        const int jt0 = 9 * q, ntile = 9;
        __syncthreads();
        if (F.tid < 160) { const int i4 = F.tid;
            const f32x4 v = i4 < 128 ? *(const f32x4*)(F.in[I_CONVW] + (size_t)(i4 >> 5) * D + g * 128 + (i4 & 31) * 4) : *(const f32x4*)(F.in[I_CONVB] + g * 128 + (i4 - 128) * 4);
            *(LAS f32x4*)(CWL + i4 * 4) = v; }
        bf16x8 fa[2][4], fx[2][4]; f32x4 bav[2], bxv[2], splv[2];
        const int ch0 = g * 128 + 16 * w + 4 * fq;
#pragma unroll
        for (int d = 0; d < 2; ++d) {
            const bf16* wa = LW + (size_t)((d * 2 + 0) * 8 + g) * 16384 + (size_t)(16 * w + fr) * 128 + fq * 8;
            const bf16* wx = LW + (size_t)((d * 2 + 1) * 8 + g) * 16384 + (size_t)(16 * w + fr) * 128 + fq * 8;
#pragma unroll
            for (int kk = 0; kk < 4; ++kk) { fa[d][kk] = *(const bf16x8*)(wa + kk * 32); fx[d][kk] = *(const bf16x8*)(wx + kk * 32); }
            bav[d] = *(const f32x4*)(F.in[I_BA] + d * D + ch0) * -1.44269504089f; bxv[d] = *(const f32x4*)(F.in[I_BX] + d * D + ch0) * -1.44269504089f; splv[d] = *(const f32x4*)((const float*)(F.ws + WS_SPL) + d * D + ch0);
        }
#define LRU_XLOAD(JT) do { const int jt_ = (JT); const bool ic_ = jt_ < 4; const int r0_ = ic_ ? TL + b * CTXL + jt_ * 64 : b * SEQ + (jt_ - 4) * 64; const int plo_ = ic_ ? -jt_ * 64 : 0, phi_ = ic_ ? CTXL - 1 - jt_ * 64 : 63; \
        _Pragma("unroll") for (int hh = 0; hh < 2; ++hh) _Pragma("unroll") for (int k = 0; k < 4; ++k) { const int pp_ = pr + 32 * hh + k - 2; const int pc_ = (pp_ >= plo_ && pp_ <= phi_) ? pp_ : 0; \
            xv[hh][k] = *(const u32x4*)(PAX + (size_t)(r0_ + pc_) * D + g * 128 + c8); } } while (0)
        u32x4 xv[2][4];
        LRU_XLOAD(jt0);
        __builtin_amdgcn_s_waitcnt(0x0F70);
        __syncthreads();
#pragma unroll 1
        for (int ti = 0; ti < ntile; ++ti) {
            const int jt = jt0 + ti;
            const bool isctx = jt < 4;
            const int row0 = isctx ? TL + b * CTXL + jt * 64 : b * SEQ + (jt - 4) * 64;
            const int plo = isctx ? -jt * 64 : 0, phi = isctx ? CTXL - 1 - jt * 64 : 63;
            {
                f32x4 w0[4], w1[4];
#pragma unroll
                for (int k = 0; k < 4; ++k) { w0[k] = *(const LAS f32x4*)(CWL + k * 128 + c8); w1[k] = *(const LAS f32x4*)(CWL + k * 128 + c8 + 4); }
                const f32x4 b0 = *(const LAS f32x4*)(CWL + 512 + c8), b1 = *(const LAS f32x4*)(CWL + 512 + c8 + 4);
#pragma unroll
                for (int hh = 0; hh < 2; ++hh) { f32x4 o0 = b0, o1 = b1;
#pragma unroll
                    for (int k = 0; k < 4; ++k) { const u32x4 x = xv[hh][k]; const int pp = pr + 32 * hh + k - 2; const float m = (pp >= plo && pp <= phi) ? 1.0f : 0.0f;
                        o0 += (w0[k] * m) * (f32x4){bflo(x.x), bfhi(x.x), bflo(x.y), bfhi(x.y)}; o1 += (w1[k] * m) * (f32x4){bflo(x.z), bfhi(x.z), bflo(x.w), bfhi(x.w)}; }
                    u32x4 wv; wv.x = pkbf(o0[0], o0[1]); wv.y = pkbf(o0[2], o0[3]); wv.z = pkbf(o1[0], o1[1]); wv.w = pkbf(o1[2], o1[3]);
                    *(LAS u32x4*)(UL + (pr + 32 * hh) * LRU_U_STRIDE + c8 * 2) = wv; }
            }
            __syncthreads();
#pragma unroll
            for (int d = 0; d < 2; ++d) {
                LAS float* Ad = AF + (size_t)(2 * d) * 8192; LAS float* Bd = AF + (size_t)(2 * d + 1) * 8192;
#pragma unroll
                for (int tt = 0; tt < 4; ++tt) { const int t = 16 * tt + fr;
                    bf16x8 ub[4]; f32x4 ga = (f32x4){0.f, 0.f, 0.f, 0.f}, gx = (f32x4){0.f, 0.f, 0.f, 0.f};
#pragma unroll
                    for (int kk = 0; kk < 4; ++kk) ub[kk] = *(const LAS bf16x8*)(UL + (16 * tt + fr) * LRU_U_STRIDE + kk * 64 + fq * 16);
#pragma unroll
                    for (int kk = 0; kk < 4; ++kk) { ga = __builtin_amdgcn_mfma_f32_16x16x32_bf16(fa[d][kk], ub[kk], ga, 0, 0, 0); gx = __builtin_amdgcn_mfma_f32_16x16x32_bf16(fx[d][kk], ub[kk], gx, 0, 0, 0); }
                    const u32x2 uu = *(const LAS u32x2*)(UL + t * LRU_U_STRIDE + (16 * w + 4 * fq) * 2);
                    const float uf[4] = {bflo(uu.x), bfhi(uu.x), bflo(uu.y), bfhi(uu.y)};
                    f32x4 av, bv;
#pragma unroll
                    for (int r = 0; r < 4; ++r) {
                        const float rg = __builtin_amdgcn_rcpf(1.0f + __builtin_amdgcn_exp2f(__builtin_fmaf(ga[r], -1.44269504089f, bav[d][r])));
                        const float ig = __builtin_amdgcn_rcpf(1.0f + __builtin_amdgcn_exp2f(__builtin_fmaf(gx[r], -1.44269504089f, bxv[d][r])));
                        const float t2 = -rg * splv[d][r];
                        const float omx = 1.0f - __builtin_amdgcn_exp2f(t2 + t2);
                        av[r] = t2; bv[r] = __builtin_amdgcn_sqrtf(omx) * ig * uf[r]; }
                    const int cs_ = (16 * w + 4 * fq) ^ ((t & 15) << 2);
                    *(LAS f32x4*)(Ad + t * 128 + cs_) = av; *(LAS f32x4*)(Bd + t * 128 + cs_) = bv; }
            }
            __syncthreads();
            if (ti + 1 < ntile) { LRU_XLOAD(jt + 1); }
            if (F.wave < 4) {
                const int d = F.wave >> 1, ch = F.tid & 127, gc = g * 128 + ch;
                LAS float* Ad = AF + (size_t)(2 * d) * 8192 + ch; LAS float* Bd = AF + (size_t)(2 * d + 1) * 8192 + ch;
                float h = 0.f, ap = 1.f;
#pragma unroll 8
                for (int s = 0; s < 64; ++s) { const int t = d ? 63 - s : s; const int o_ = t * 128 + (ch ^ ((t & 15) << 2)) - ch; const float a = __builtin_amdgcn_exp2f(Ad[o_]), bb = Bd[o_]; h = a * h + bb; ap *= a; }
                AGG[(((size_t)(0 * 2 + d) * NB + b) * 36 + jt) * D + gc] = ap; AGG[(((size_t)(1 * 2 + d) * NB + b) * 36 + jt) * D + gc] = h;
            }
            if (!isctx) {
                constexpr unsigned dofs[4] = {(unsigned)WS_T1, (unsigned)WS_MM, (unsigned)WS_H2, (unsigned)WS_A2};
#pragma unroll
                for (int hh = 0; hh < 2; ++hh) { const int p = pr + 32 * hh; const unsigned voff = (unsigned)(((row0 + p) * D + g * 128 + c8) * 2);
#pragma unroll
                    for (int k4 = 0; k4 < 4; ++k4) { const LAS float* sp = AF + (size_t)k4 * 8192 + p * 128; const int sw_ = (p & 15) << 2;
                        const f32x4 x0 = *(const LAS f32x4*)(sp + (c8 ^ sw_)), x1 = *(const LAS f32x4*)(sp + ((c8 + 4) ^ sw_));
                        *(u32x4*)(F.ws + (size_t)(dofs[k4] + voff)) = (u32x4){pkbf(x0[0], x0[1]), pkbf(x0[2], x0[3]), pkbf(x1[0], x1[1]), pkbf(x1[2], x1[3])}; } }
            }
            __syncthreads();
        }
#undef LRU_XLOAD
    }
}

__device__ __forceinline__ void lru_pass2_stream(const Frame& F, int widx, int nw) {
    const bf16* PAG = (const bf16*)(F.ws + WS_P) + PG_STRIDE;
    const bf16* const src[4] = {(const bf16*)(F.ws + WS_T1), (const bf16*)(F.ws + WS_MM), (const bf16*)(F.ws + WS_H2), (const bf16*)(F.ws + WS_A2)};
    const float* AGG = (const float*)(F.ws + WS_AGG);
    bf16* A1 = (bf16*)(F.ws + WS_A1);
    LAS float* AF = (LAS float*)F.lds;
    const int c8 = (F.tid & 15) * 8, pr = F.tid >> 4;
    for (int vw = widx; vw < 256; vw += nw) {
        const int g = vw & 7, b = (vw >> 3) & 7, q = vw >> 6, jt0 = 4 + 8 * q;
        float cin[8];
#pragma unroll
        for (int i = 0; i < 8; ++i) cin[i] = 0.f;
        if (F.wave < 4) {
            const int d = F.wave >> 1, gc = g * 128 + (F.tid & 127);
            const float* aggA = AGG + ((size_t)(0 * 2 + d) * NB + b) * 36 * D; const float* aggH = AGG + ((size_t)(1 * 2 + d) * NB + b) * 36 * D;
            float ca[36], chh[36];
            if (d == 0) {
#pragma unroll
                for (int k = 0; k < 36; ++k) { ca[k] = aggA[(size_t)k * D + gc]; chh[k] = aggH[(size_t)k * D + gc]; }
            } else {
#pragma unroll
                for (int k = 0; k < 36; ++k) { const int sq = k < 4 ? 3 - k : 39 - k; ca[k] = aggA[(size_t)sq * D + gc]; chh[k] = aggH[(size_t)sq * D + gc]; }
            }
            float h = 0.f;
#pragma unroll
            for (int k = 0; k < 36; ++k) { const int sq = d ? (k < 4 ? 3 - k : 39 - k) : k;
#pragma unroll
                for (int i = 0; i < 8; ++i) cin[i] = (sq == jt0 + i) ? h : cin[i];
                h = ca[k] * h + chh[k]; }
        }
        u32x4 cur[4][2], gg[2];
#define L2_LOAD(TI, DST, GG) do { const int row_ = b * SEQ + (jt0 + (TI) - 4) * 64; \
        _Pragma("unroll") for (int k4 = 0; k4 < 4; ++k4) _Pragma("unroll") for (int hh = 0; hh < 2; ++hh) DST[k4][hh] = *(const u32x4*)(src[k4] + (size_t)(row_ + pr + 32 * hh) * D + g * 128 + c8); \
        _Pragma("unroll") for (int hh = 0; hh < 2; ++hh) GG[hh] = *(const u32x4*)(PAG + (size_t)(row_ + pr + 32 * hh) * D + g * 128 + c8); } while (0)
        L2_LOAD(0, cur, gg);
#pragma unroll 1
        for (int ti = 0; ti < 8; ++ti) {
            const int row0 = b * SEQ + (jt0 + ti - 4) * 64;
#pragma unroll
            for (int k4 = 0; k4 < 4; ++k4)
#pragma unroll
                for (int hh = 0; hh < 2; ++hh) { const u32x4 v = cur[k4][hh]; f32x4 x0 = (f32x4){bflo(v.x), bfhi(v.x), bflo(v.y), bfhi(v.y)}, x1 = (f32x4){bflo(v.z), bfhi(v.z), bflo(v.w), bfhi(v.w)};
                    if ((k4 & 1) == 0) {
#pragma unroll
                        for (int i = 0; i < 4; ++i) { x0[i] = __builtin_amdgcn_exp2f(x0[i]); x1[i] = __builtin_amdgcn_exp2f(x1[i]); } }
                    LAS float* dp = AF + (size_t)k4 * 8192 + (pr + 32 * hh) * 128 + c8; *(LAS f32x4*)dp = x0; *(LAS f32x4*)(dp + 4) = x1; }
            const u32x4 gcur0 = gg[0], gcur1 = gg[1];
            if (ti + 1 < 8) { L2_LOAD(ti + 1, cur, gg); }
            __syncthreads();
            if (F.wave < 4) {
                const int d = F.wave >> 1, ch = F.tid & 127;
                LAS float* Ad = AF + (size_t)(2 * d) * 8192 + ch; LAS float* Bd = AF + (size_t)(2 * d + 1) * 8192 + ch;
                float h = cin[0];
#pragma unroll
                for (int i = 1; i < 8; ++i) h = (ti == i) ? cin[i] : h;
#pragma unroll 8
                for (int s = 0; s < 64; ++s) { const int t = d ? 63 - s : s; const float a = Ad[t * 128], bb = Bd[t * 128]; h = a * h + bb; Bd[t * 128] = h; }
            }
            __syncthreads();
#pragma unroll
            for (int hh = 0; hh < 2; ++hh) { const int p = pr + 32 * hh;
                const LAS float* h0 = AF + 8192 + p * 128 + c8; const LAS float* h1 = AF + 3 * 8192 + p * 128 + c8;
                const f32x4 x0 = *(const LAS f32x4*)h0, x1 = *(const LAS f32x4*)(h0 + 4), y0 = *(const LAS f32x4*)h1, y1 = *(const LAS f32x4*)(h1 + 4);
                const u32x4 gv = hh ? gcur1 : gcur0;
                u32x4 o; o.x = pkbf((x0[0] + y0[0]) * bflo(gv.x), (x0[1] + y0[1]) * bfhi(gv.x)); o.y = pkbf((x0[2] + y0[2]) * bflo(gv.y), (x0[3] + y0[3]) * bfhi(gv.y));
                o.z = pkbf((x1[0] + y1[0]) * bflo(gv.z), (x1[1] + y1[1]) * bfhi(gv.z)); o.w = pkbf((x1[2] + y1[2]) * bflo(gv.w), (x1[3] + y1[3]) * bfhi(gv.w));
                *(u32x4*)(A1 + (size_t)(row0 + p) * D + g * 128 + c8) = o; }
            __syncthreads();
        }
#undef L2_LOAD
    }
}

constexpr int HG_QT = 0, HG_KT = 9216, HG_QH = 18432, HG_KHT = 27648, HG_VT = 36864, HG_PS = 55296, HG_ST0 = 64512, HG_ST1 = 82944, HG_SEG = 101376, HG_DEC = 105472;
constexpr int HG_VB1 = 139520;
constexpr int HG_INV = 139264;
constexpr int HS64 = 144;
#define HG_SYNC() asm volatile("s_waitcnt lgkmcnt(0)\n\ts_barrier" ::: "memory")
__device__ __forceinline__ void hgrn_phase(const Frame& F) {
    const bf16* PQ = (const bf16*)(F.ws + WS_P) + 2 * PG_STRIDE;
    const bf16* PV = (const bf16*)(F.ws + WS_P) + 5 * PG_STRIDE;
    LAS unsigned char* L = F.lds;
    const int fr = F.lane & 15, fq = F.lane >> 4, w = F.wave, lane = F.lane;
    if (F.tid < 32) ((LAS float*)(L + HG_INV))[F.tid] = ((const float*)(F.ws + WS_SW1))[32 + F.tid];
    __syncthreads();
    for (int it = F.vcu; it < 256; it += F.G) {
        const int dh = it & 1, dir = (it >> 1) & 1, h = (it >> 2) & 7, b = it >> 5;
        const bf16* PF = (const bf16*)(F.ws + WS_P) + (size_t)(3 + dir) * PG_STRIDE;
        bf16* OUT = (bf16*)(F.ws + (dir ? (dh ? WS_X1 + 32 * MiB : WS_OB) : (dh ? WS_X1 : WS_OF)));
        const int dp = lane & 31, ph = lane >> 5, d0 = 2 * dp;
        const int dcol = h * 128 + 64 * dh + d0;
        float lb0, lb1;
        { const float* ll = F.in[I_LBL]; const float a0 = ll[dcol], a1 = ll[dcol + 1], c0 = ll[D + dcol], c1 = ll[D + dcol + 1];
          lb0 = 1.0f / (1.0f + __expf(c0 - a0)); lb1 = 1.0f / (1.0f + __expf(c1 - a1)); }
        f32x4 S[4];
#pragma unroll
        for (int j = 0; j < 4; ++j) S[j] = (f32x4){0.f, 0.f, 0.f, 0.f};
        unsigned vt2[4], vt3[4];
        { const unsigned q_ = (unsigned)fr >> 2, p_ = (unsigned)fr & 3u, x_ = (q_ << 2) | (unsigned)fq, vb_ = (unsigned)(size_t)(L + HG_VT) + 256u * (4u * (unsigned)fq + q_) + 8u * (p_ & 1u);
#pragma unroll
          for (int j = 0; j < 4; ++j) { const unsigned e2 = (unsigned)((w & 1) * 4 + j), e3 = (unsigned)((w >> 2) * 4 + j);
              vt2[j] = vb_ + 16u * ((2u * e2 + (p_ >> 1)) ^ x_); vt3[j] = vb_ + 16u * ((2u * e3 + (p_ >> 1)) ^ x_); } }
        typedef short s16x4 __attribute__((ext_vector_type(4)));
#define HG_TR16(B, O) asm volatile( \
            "ds_read_b64_tr_b16 %0, %16\n\tds_read_b64_tr_b16 %1, %16 offset:4096\n\tds_read_b64_tr_b16 %2, %16 offset:8192\n\tds_read_b64_tr_b16 %3, %16 offset:12288\n\t" \
            "ds_read_b64_tr_b16 %4, %17\n\tds_read_b64_tr_b16 %5, %17 offset:4096\n\tds_read_b64_tr_b16 %6, %17 offset:8192\n\tds_read_b64_tr_b16 %7, %17 offset:12288\n\t" \
            "ds_read_b64_tr_b16 %8, %18\n\tds_read_b64_tr_b16 %9, %18 offset:4096\n\tds_read_b64_tr_b16 %10, %18 offset:8192\n\tds_read_b64_tr_b16 %11, %18 offset:12288\n\t" \
            "ds_read_b64_tr_b16 %12, %19\n\tds_read_b64_tr_b16 %13, %19 offset:4096\n\tds_read_b64_tr_b16 %14, %19 offset:8192\n\tds_read_b64_tr_b16 %15, %19 offset:12288\n\t" \
            "s_waitcnt lgkmcnt(0)" \
            : "=&v"(O[0][0][0]), "=&v"(O[0][0][1]), "=&v"(O[0][1][0]), "=&v"(O[0][1][1]), "=&v"(O[1][0][0]), "=&v"(O[1][0][1]), "=&v"(O[1][1][0]), "=&v"(O[1][1][1]), \
              "=&v"(O[2][0][0]), "=&v"(O[2][0][1]), "=&v"(O[2][1][0]), "=&v"(O[2][1][1]), "=&v"(O[3][0][0]), "=&v"(O[3][0][1]), "=&v"(O[3][1][0]), "=&v"(O[3][1][1]) \
            : "v"(B[0]), "v"(B[1]), "v"(B[2]), "v"(B[3]) : "memory")
#define HG_VOP(O, j, kq) __builtin_shufflevector(O[j][kq][0], O[j][kq][1], 0, 1, 2, 3, 4, 5, 6, 7)
#define HG_BASE(ci) ((ci) >= 4 ? b * SEQ + 64 * (dir ? 31 - ((ci) - 4) : ((ci) - 4)) : TL + b * CTXL + 64 * (dir ? 3 - (ci) : (ci)))
#define HG_LOAD(ci, FR, QR) do { const int base_ = HG_BASE(ci); const bool lat_ = (ci) >= 4; \
        _Pragma("unroll") for (int i = 0; i < 4; ++i) { const int p_ = 8 * w + 4 * ph + i; const size_t ro_ = (size_t)(base_ + (dir ? 63 - p_ : p_)) * D + dcol; \
            FR[i] = *(const unsigned*)(PF + ro_); QR[i] = lat_ ? *(const unsigned*)(PQ + ro_) : 0u; } } while (0)
#define HG_VDMA(ci) do { const size_t cb_ = (size_t)HG_BASE(ci) * (D * 2); LAS unsigned char* vd_ = L + (((ci) & 1) ? HG_VB1 : HG_VT) + 2048 * w; \
        _Pragma("unroll") for (int k = 0; k < 2; ++k) { const int s_ = 8 * w + 4 * k + (lane >> 4); const int c_ = (lane & 15) ^ (((s_ & 3) << 2) | ((s_ >> 2) & 3)); \
            __builtin_amdgcn_global_load_lds((const unsigned*)((const char*)PV + cb_ + (size_t)(((dir ? 63 - s_ : s_) * D + h * 128) * 2 + 16 * c_)), (LAS unsigned*)(vd_ + 1024 * k), 16, 0, 0); } } while (0)
        unsigned fraw[4], qraw[4];
        HG_LOAD(0, fraw, qraw);
        unsigned fn[4], qn[4];
        HG_LOAD(1, fn, qn);
        HG_VDMA(0);
        float cs[4][2], kk[4][2];
#define HG_E1(FR) do { float run0_ = 0.f, run1_ = 0.f; \
        _Pragma("unroll") for (int i = 0; i < 4; ++i) { \
            const float f0_ = lb0 + (1.0f - lb0) * fast_sigmoid(bflo(FR[i])), f1_ = lb1 + (1.0f - lb1) * fast_sigmoid(bfhi(FR[i])); \
            run0_ += __builtin_amdgcn_logf(f0_); run1_ += __builtin_amdgcn_logf(f1_); \
            cs[i][0] = run0_; cs[i][1] = run1_; kk[i][0] = 1.0f - f0_; kk[i][1] = 1.0f - f1_; } \
        *(LAS f32x2*)(L + HG_SEG + ((2 * w + ph) * 64 + d0) * 4) = (f32x2){run0_, run1_}; } while (0)
        HG_E1(fraw);
        int pitem = -1;
        LAS unsigned char* fscr = L + 106496 + w * 4096;
        for (int ci = 0; ci < 36; ++ci) {
            const bool lat = ci >= 4;
            const int base = HG_BASE(ci);
            unsigned f2[4], q2[4];
#pragma unroll
            for (int i = 0; i < 4; ++i) { f2[i] = 0u; q2[i] = 0u; }
            const int fitem = ci * ((F.G < 256 ? F.G : 256) * NWAVES) + F.vcu * NWAVES + w;
            const bool fdo = fitem < MOE_ITEMS && it < F.G && (F.G != 256 || ci < HG_FILL_CH);
            asm volatile("s_waitcnt vmcnt(0)" ::: "memory");
            if (pitem >= 0) { MoeItem pm_ = moe_item<false>(F, pitem); pm_.inv = ((const LAS float*)(L + HG_INV))[(pitem >> 11) & 31]; moe_dma_finish(pm_, lane, fscr); }
            if (ci + 2 < 36) { HG_LOAD(ci + 2, f2, q2); }
            if (fdo) { moe_dma_issue(moe_item<false>(F, fitem), lane, fscr); }
            pitem = fdo ? fitem : -1;
            const int sidx = 2 * w + ph;
            HG_SYNC();
            if (ci + 1 < 36) { HG_VDMA(ci + 1); }
            float off0, off1, mid0, mid1, end0, end1;
            f32x2 sgv[16];
#pragma unroll
            for (int ww = 0; ww < 16; ++ww) sgv[ww] = *(const LAS f32x2*)(L + HG_SEG + (ww * 64 + d0) * 4);
            const f32x2 sgw = *(const LAS f32x2*)(L + HG_SEG + ((2 * w) * 64 + d0) * 4);
            asm volatile("s_waitcnt lgkmcnt(0)" ::: "memory");
            {
                const int w2 = (w & 3) * 2;
                f32x2 lo = (f32x2){0.f, 0.f}, hi = (f32x2){0.f, 0.f}, cl = lo, ch = hi;
#pragma unroll
                for (int k = 0; k < 8; ++k) {
                    if ((k & 1) == 0) { cl.x = (k == w2) ? lo.x : cl.x; cl.y = (k == w2) ? lo.y : cl.y; ch.x = (k == w2) ? hi.x : ch.x; ch.y = (k == w2) ? hi.y : ch.y; }
                    lo += sgv[k]; hi += sgv[8 + k]; }
                mid0 = lo.x; mid1 = lo.y; end0 = lo.x + hi.x; end1 = lo.y + hi.y;
                const bool up = w >= 4;
                off0 = (up ? mid0 + ch.x : cl.x) + (ph ? sgw.x : 0.f); off1 = (up ? mid1 + ch.y : cl.y) + (ph ? sgw.y : 0.f);
            }
            const float emid0 = __builtin_amdgcn_exp2f(mid0), emid1 = __builtin_amdgcn_exp2f(mid1);
            const float eem0 = __builtin_amdgcn_exp2f(end0 - mid0), eem1 = __builtin_amdgcn_exp2f(end1 - mid1);
            unsigned kh0[2], kh1[2];
            {
                float em[4][2], kt[4][2];
#pragma unroll
                for (int i = 0; i < 4; ++i) { const float g0 = off0 + cs[i][0], g1 = off1 + cs[i][1];
                    em[i][0] = __builtin_amdgcn_exp2f(g0 - mid0); em[i][1] = __builtin_amdgcn_exp2f(g1 - mid1);
                    kt[i][0] = kk[i][0] * __builtin_amdgcn_rcpf(em[i][0]); kt[i][1] = kk[i][1] * __builtin_amdgcn_rcpf(em[i][1]); }
                unsigned wq[4], wk[4], wh[4];
#pragma unroll
                for (int i = 0; i < 4; ++i) { const float qt0 = bflo(qraw[i]) * em[i][0], qt1 = bfhi(qraw[i]) * em[i][1];
                    wq[i] = pkbf(qt0, qt1); wk[i] = pkbf(kt[i][0], kt[i][1]); wh[i] = pkbf(qt0 * emid0, qt1 * emid1); }
                if (lat) {
#pragma unroll
                    for (int i = 0; i < 4; ++i) { const int p = 8 * w + 4 * ph + i;
                        *(LAS unsigned*)(L + HG_QT + p * HS64 + d0 * 2) = wq[i]; *(LAS unsigned*)(L + HG_KT + p * HS64 + d0 * 2) = wk[i]; *(LAS unsigned*)(L + HG_QH + p * HS64 + d0 * 2) = wh[i]; }
                }
                kh0[0] = pkbf(kt[0][0] * eem0, kt[1][0] * eem0); kh0[1] = pkbf(kt[2][0] * eem0, kt[3][0] * eem0);
                kh1[0] = pkbf(kt[0][1] * eem1, kt[1][1] * eem1); kh1[1] = pkbf(kt[2][1] * eem1, kt[3][1] * eem1);
            }
            const int spos = 32 * (w >> 2) + 16 * (w & 1) + 4 * ((w >> 1) & 1);
            *(LAS u32x2*)(L + HG_KHT + d0 * HS64 + (spos + 8 * ph) * 2) = (u32x2){kh0[0], kh0[1]};
            *(LAS u32x2*)(L + HG_KHT + (d0 + 1) * HS64 + (spos + 8 * ph) * 2) = (u32x2){kh1[0], kh1[1]};
            if (sidx == 0) *(LAS f32x2*)(L + HG_DEC + d0 * 4) = (f32x2){emid0 * eem0, emid1 * eem1};
            HG_SYNC();
            const int stoff = (ci & 1) ? HG_ST1 : HG_ST0, stnext = (ci & 1) ? HG_ST0 : HG_ST1;
            const unsigned vimg = (ci & 1) ? (unsigned)(HG_VB1 - HG_VT) : 0u;
            if (lat) {
                const int pt = w >> 1;
                bf16x8 ps[2], qh[2];
                {
                    bf16x8 qt[2];
#pragma unroll
                    for (int kq = 0; kq < 2; ++kq) { qt[kq] = *(const LAS bf16x8*)(L + HG_QT + (16 * pt + fr) * HS64 + kq * 64 + fq * 16); qh[kq] = *(const LAS bf16x8*)(L + HG_QH + (16 * pt + fr) * HS64 + kq * 64 + fq * 16); }
                    f32x4 sc[4];
#pragma unroll
                    for (int st = 0; st < 4; ++st) { sc[st] = (f32x4){0.f, 0.f, 0.f, 0.f};
#pragma unroll
                        for (int kq = 0; kq < 2; ++kq) { const bf16x8 xa = *(const LAS bf16x8*)(L + HG_KT + (16 * st + fr) * HS64 + kq * 64 + fq * 16);
                            sc[st] = __builtin_amdgcn_mfma_f32_16x16x32_bf16(xa, qt[kq], sc[st], 0, 0, 0); }
                        const int pp = 16 * pt + fr, s0 = 16 * st + 4 * fq;
#pragma unroll
                        for (int r = 0; r < 4; ++r) sc[st][r] = (s0 + r <= pp) ? sc[st][r] : 0.f; }
#pragma unroll
                    for (int kq = 0; kq < 2; ++kq) { const u32x4 t4 = (u32x4){pkbf(sc[2 * kq][0], sc[2 * kq][1]), pkbf(sc[2 * kq][2], sc[2 * kq][3]), pkbf(sc[2 * kq + 1][0], sc[2 * kq + 1][1]), pkbf(sc[2 * kq + 1][2], sc[2 * kq + 1][3])};
                        ps[kq] = __builtin_bit_cast(bf16x8, t4); }
                }
                const int p = 16 * pt + fr, tok = base + (dir ? 63 - p : p);
                s16x4 vq[4][2][2];
                { const unsigned b2_[4] = {vt2[0] + vimg, vt2[1] + vimg, vt2[2] + vimg, vt2[3] + vimg}; HG_TR16(b2_, vq); }
#pragma unroll
                for (int j = 0; j < 4; ++j) { const int et = (w & 1) * 4 + j;
                    f32x4 a = (f32x4){0.f, 0.f, 0.f, 0.f};
#pragma unroll
                    for (int kq = 0; kq < 2; ++kq) { const bf16x8 xa = HG_VOP(vq, j, kq);
                        a = __builtin_amdgcn_mfma_f32_16x16x32_bf16(xa, ps[kq], a, 0, 0, 0); }
#pragma unroll
                    for (int kq = 0; kq < 2; ++kq) { const bf16x8 xa = *(const LAS bf16x8*)(L + stoff + (16 * et + fr) * HS64 + kq * 64 + fq * 16);
                        a = __builtin_amdgcn_mfma_f32_16x16x32_bf16(xa, qh[kq], a, 0, 0, 0); }
                    u32x2 wv; wv.x = pkbf(a[0], a[1]); wv.y = pkbf(a[2], a[3]);
                    *(u32x2*)(OUT + (size_t)tok * D + h * 128 + 16 * et + 4 * fq) = wv; }
            }
            { const int dt = w & 3;
              const f32x4 dc = *(const LAS f32x4*)(L + HG_DEC + (16 * dt + 4 * fq) * 4);
              bf16x8 xa[2];
#pragma unroll
              for (int kq = 0; kq < 2; ++kq) xa[kq] = *(const LAS bf16x8*)(L + HG_KHT + (16 * dt + fr) * HS64 + kq * 64 + fq * 16);
              s16x4 vy[4][2][2];
              { const unsigned b3_[4] = {vt3[0] + vimg, vt3[1] + vimg, vt3[2] + vimg, vt3[3] + vimg}; HG_TR16(b3_, vy); }
#pragma unroll
              for (int j = 0; j < 4; ++j) { const int et = (w >> 2) * 4 + j; S[j] = S[j] * dc;
#pragma unroll
                  for (int kq = 0; kq < 2; ++kq) { const bf16x8 yb = HG_VOP(vy, j, kq);
                      S[j] = __builtin_amdgcn_mfma_f32_16x16x32_bf16(xa[kq], yb, S[j], 0, 0, 0); }
                  u32x2 wv; wv.x = pkbf(S[j][0], S[j][1]); wv.y = pkbf(S[j][2], S[j][3]);
                  *(LAS u32x2*)(L + stnext + (16 * et + fr) * HS64 + (16 * dt + 4 * fq) * 2) = wv; } }
            if (ci + 1 < 36) { HG_E1(fn); }
#pragma unroll
            for (int i = 0; i < 4; ++i) { fraw[i] = fn[i]; qraw[i] = qn[i]; fn[i] = f2[i]; qn[i] = q2[i]; }
        }
        if (pitem >= 0) { asm volatile("s_waitcnt vmcnt(0)" ::: "memory"); MoeItem pm_ = moe_item<false>(F, pitem); pm_.inv = ((const LAS float*)(L + HG_INV))[(pitem >> 11) & 31]; moe_dma_finish(pm_, lane, fscr); }
        HG_SYNC();
#undef HG_BASE
#undef HG_TR16
#undef HG_VOP
#undef HG_LOAD
#undef HG_VDMA
#undef HG_E1
    }
}

__device__ __forceinline__ void p5_readout(const Frame& F) {
    const int gw = F.vcu * NWAVES + F.wave, NGW = F.G * NWAVES;
    const bf16* OFp = (const bf16*)(F.ws + WS_OF); const bf16* OBp = (const bf16*)(F.ws + WS_OB); const bf16* OF1 = (const bf16*)(F.ws + WS_X1); const bf16* OB1 = (const bf16*)(F.ws + WS_X1 + 32 * MiB);
    const bf16* SG = (const bf16*)(F.ws + WS_P) + 6 * PG_STRIDE; bf16* A2 = (bf16*)(F.ws + WS_A2);
    const float* gn = F.in[I_HGG];
    const int c0 = 16 * F.lane, e0 = c0 & 127;
    for (int r = gw; r < TL; r += NGW) {
        const size_t off = (size_t)r * D + c0;
        const u32x4 a0 = *(const u32x4*)(OFp + off), a1 = *(const u32x4*)(OFp + off + 8), b0 = *(const u32x4*)(OBp + off), b1 = *(const u32x4*)(OBp + off + 8);
        const u32x4 c0v = *(const u32x4*)(OF1 + off), c1v = *(const u32x4*)(OF1 + off + 8), d0v = *(const u32x4*)(OB1 + off), d1v = *(const u32x4*)(OB1 + off + 8);
        const u32x4 s0 = *(const u32x4*)(SG + off), s1 = *(const u32x4*)(SG + off + 8);
        const unsigned aa[8] = {a0.x, a0.y, a0.z, a0.w, a1.x, a1.y, a1.z, a1.w}, bb[8] = {b0.x, b0.y, b0.z, b0.w, b1.x, b1.y, b1.z, b1.w}, sg[8] = {s0.x, s0.y, s0.z, s0.w, s1.x, s1.y, s1.z, s1.w};
        const unsigned cc[8] = {c0v.x, c0v.y, c0v.z, c0v.w, c1v.x, c1v.y, c1v.z, c1v.w}, dd[8] = {d0v.x, d0v.y, d0v.z, d0v.w, d1v.x, d1v.y, d1v.z, d1v.w};
        float o[16]; float ss = 0.f;
#pragma unroll
        for (int q = 0; q < 8; ++q) { o[2 * q] = (bflo(aa[q]) + bflo(cc[q])) + (bflo(bb[q]) + bflo(dd[q])); o[2 * q + 1] = (bfhi(aa[q]) + bfhi(cc[q])) + (bfhi(bb[q]) + bfhi(dd[q])); ss += o[2 * q] * o[2 * q] + o[2 * q + 1] * o[2 * q + 1]; }
        ss += __shfl_xor(ss, 1); ss += __shfl_xor(ss, 2); ss += __shfl_xor(ss, 4);
        const float rstd = 1.0f / sqrtf(ss * (1.0f / 128.0f) + EPS);
        unsigned wv[8];
#pragma unroll
        for (int q = 0; q < 8; ++q) wv[q] = pk2(o[2 * q] * rstd * gn[e0 + 2 * q] * bflo(sg[q]), o[2 * q + 1] * rstd * gn[e0 + 2 * q + 1] * bfhi(sg[q]));
        *(u32x4*)(A2 + off) = (u32x4){wv[0], wv[1], wv[2], wv[3]}; *(u32x4*)(A2 + off + 8) = (u32x4){wv[4], wv[5], wv[6], wv[7]};
    }
}

constexpr int R9_HTS = 1028;
constexpr int R9_PART = 16 * R9_HTS * 4;
template <int CTRL> __device__ __forceinline__ float dppf(float v) { return __int_as_float(__builtin_amdgcn_update_dpp(0, __float_as_int(v), CTRL, 0xF, 0xF, true)); }
template <int CTRL> __device__ __forceinline__ int dppi(int v) { return __builtin_amdgcn_update_dpp(0, v, CTRL, 0xF, 0xF, true); }
__device__ __forceinline__ void p9_route(const Frame& F) {
    LAS float* HT = (LAS float*)F.lds; LAS float* PART = (LAS float*)(F.lds + R9_PART);
    const int lane = F.lane, w = F.wave, fr = lane & 15, fq = lane >> 4;
    const bf16* X1 = (const bf16*)(F.ws + WS_X1); const float* mod = (const float*)(F.ws + WS_MOD); unsigned char* H2 = F.ws + WS_H2; float* SCL = (float*)(F.ws + WS_SCL);
    const float* g2 = F.in[I_N2G];
    unsigned* cnt = (unsigned*)(F.ws + WS_CTL) + CW_CNT;
    int* TE = (int*)(F.ws + WS_ROUTE); int* TP = TE + TL * 4; float* TG = (float*)(TP + TL * 4); int* LIST = (int*)(F.ws + WS_LIST);
    LAS unsigned* ALIST = (LAS unsigned*)(F.lds + 147456);
    LAS int* HIST = (LAS int*)(F.lds + 149504); LAS int* BASE = HIST + 32; LAS float* TSC = (LAS float*)(BASE + 32);
    if (F.tid < 32) HIST[F.tid] = 0;
    float bfr[8][4][2];
    { const float* rw = F.in[I_RW] + (size_t)(128 * w + 4 * fq) * 32 + fr;
#pragma unroll
      for (int S = 0; S < 8; ++S)
#pragma unroll
          for (int c = 0; c < 4; ++c)
#pragma unroll
              for (int et = 0; et < 2; ++et) bfr[S][c][et] = rw[(size_t)(16 * S + c) * 32 + et * 16]; }
    __syncthreads();
    const int e_l = lane & 31, hu = lane >> 5;
    const float rbias = F.in[I_RB][e_l];
    const int tpw = (TL + F.G - 1) / F.G, t0 = F.vcu * tpw, t1 = (t0 + tpw < TL) ? t0 + tpw : TL;
    int curb = -1; float gk[16], sk[16];
#pragma unroll
    for (int j = 0; j < 16; ++j) { gk[j] = 0.f; sk[j] = 0.f; }
    int n = 0;
    u32x2 nx[2][4];
#define R9_XLOAD(T0) do { const int a_ = (T0) + w, b_ = (T0) + 8 + w; const int ta_ = a_ < t1 ? a_ : t0, tb_ = b_ < t1 ? b_ : ta_; \
        _Pragma("unroll") for (int j = 0; j < 4; ++j) { nx[0][j] = *(const u32x2*)(X1 + (size_t)ta_ * D + 4 * lane + 256 * j); nx[1][j] = *(const u32x2*)(X1 + (size_t)tb_ * D + 4 * lane + 256 * j); } } while (0)
    R9_XLOAD(t0);
    for (int tile0 = t0; tile0 < t1; tile0 += 16, n += 2) {
        const int tA = tile0 + w, tB = tile0 + 8 + w;
        const bool hasA = tA < t1, has2 = tB < t1;
        const int tt[2] = {hasA ? tA : t0, has2 ? tB : (hasA ? tA : t0)};
        if ((tt[0] >> 11) != curb) { curb = tt[0] >> 11; const float* mv = mod + (size_t)curb * NMOD;
#pragma unroll
            for (int j = 0; j < 4; ++j) { const int k = 4 * lane + 256 * j; const f32x4 gv = *(const f32x4*)(g2 + k), m4 = *(const f32x4*)(mv + 4 * D + k), m3 = *(const f32x4*)(mv + 3 * D + k);
#pragma unroll
                for (int i = 0; i < 4; ++i) { gk[4 * j + i] = gv[i] * (1.0f + m4[i]); sk[4 * j + i] = m3[i]; } } }
        float xv[2][16]; float ss[2] = {0.f, 0.f};
#pragma unroll
        for (int u = 0; u < 2; ++u)
#pragma unroll
            for (int j = 0; j < 4; ++j) { const u32x2 vb = nx[u][j]; const f32x4 v = (f32x4){bflo(vb.x), bfhi(vb.x), bflo(vb.y), bfhi(vb.y)};
#pragma unroll
                for (int i = 0; i < 4; ++i) { xv[u][4 * j + i] = v[i]; ss[u] += v[i] * v[i]; } }
        R9_XLOAD(tile0 + 16);
        float rstd[2];
#define R9_RED(OP, A, B) do { A = OP(A, dppf<0xB1>(A)); B = OP(B, dppf<0xB1>(B)); A = OP(A, dppf<0x4E>(A)); B = OP(B, dppf<0x4E>(B)); A = OP(A, dppf<0x141>(A)); B = OP(B, dppf<0x141>(B)); \
        A = OP(A, dppf<0x140>(A)); B = OP(B, dppf<0x140>(B)); A = OP(A, __shfl_xor(A, 16)); B = OP(B, __shfl_xor(B, 16)); A = OP(A, __shfl_xor(A, 32)); B = OP(B, __shfl_xor(B, 32)); } while (0)
#define R9_ADD(x, y) ((x) + (y))
        R9_RED(R9_ADD, ss[0], ss[1]);
        rstd[0] = __builtin_amdgcn_rsqf(ss[0] * (1.0f / D) + EPS); rstd[1] = __builtin_amdgcn_rsqf(ss[1] * (1.0f / D) + EPS);
        float am0 = 0.f, am1 = 0.f;
#pragma unroll
        for (int j = 0; j < 16; ++j) { xv[0][j] = xv[0][j] * rstd[0] * gk[j] + sk[j]; xv[1][j] = xv[1][j] * rstd[1] * gk[j] + sk[j]; am0 = fmaxf(am0, fabsf(xv[0][j])); am1 = fmaxf(am1, fabsf(xv[1][j])); }
        R9_RED(fmaxf, am0, am1);
#undef R9_RED
#undef R9_ADD
        const float sc0 = am0 > 0.f ? am0 * (1.0f / 127.0f) : 1.0f, sc1 = am1 > 0.f ? am1 * (1.0f / 127.0f) : 1.0f, iv0 = __builtin_amdgcn_rcpf(sc0) * 0.99999f, iv1 = __builtin_amdgcn_rcpf(sc1) * 0.99999f;
        if (lane == 0) { TSC[n * 8 + w] = sc0; TSC[(n + 1) * 8 + w] = sc1; }
#pragma unroll
        for (int j = 0; j < 4; ++j) {
            *(LAS f32x4*)(HT + w * R9_HTS + 4 * lane + 256 * j) = (f32x4){xv[0][4 * j], xv[0][4 * j + 1], xv[0][4 * j + 2], xv[0][4 * j + 3]};
            *(LAS f32x4*)(HT + (w + 8) * R9_HTS + 4 * lane + 256 * j) = (f32x4){xv[1][4 * j], xv[1][4 * j + 1], xv[1][4 * j + 2], xv[1][4 * j + 3]};
            unsigned q0[4], q1[4];
#pragma unroll
            for (int i = 0; i < 4; ++i) { q0[i] = __float_as_uint(__builtin_fmaf(xv[0][4 * j + i], iv0, 12582912.0f)); q1[i] = __float_as_uint(__builtin_fmaf(xv[1][4 * j + i], iv1, 12582912.0f)); }
            const unsigned w0 = __builtin_amdgcn_perm(__builtin_amdgcn_perm(q0[3], q0[2], 0x0c0c0400u), __builtin_amdgcn_perm(q0[1], q0[0], 0x0c0c0400u), 0x05040100u);
            const unsigned w1 = __builtin_amdgcn_perm(__builtin_amdgcn_perm(q1[3], q1[2], 0x0c0c0400u), __builtin_amdgcn_perm(q1[1], q1[0], 0x0c0c0400u), 0x05040100u);
            *(unsigned*)(H2 + (size_t)tt[0] * D + 4 * lane + 256 * j) = w0; *(unsigned*)(H2 + (size_t)tt[1] * D + 4 * lane + 256 * j) = w1; }
        __syncthreads();
        f32x4 acc[2]; acc[0] = (f32x4){0.f, 0.f, 0.f, 0.f}; acc[1] = (f32x4){0.f, 0.f, 0.f, 0.f};
#pragma unroll
        for (int S = 0; S < 8; ++S) { const f32x4 a4 = *(const LAS f32x4*)(HT + fr * R9_HTS + 128 * w + 16 * S + 4 * fq);
#pragma unroll
            for (int c = 0; c < 4; ++c)
#pragma unroll
                for (int et = 0; et < 2; ++et) acc[et] = __builtin_amdgcn_mfma_f32_16x16x4f32(a4[c], bfr[S][c][et], acc[et], 0, 0, 0); }
#pragma unroll
        for (int et = 0; et < 2; ++et)
#pragma unroll
            for (int r = 0; r < 4; ++r) PART[(w * 16 + 4 * fq + r) * 32 + et * 16 + fr] = acc[et][r];
        __syncthreads();
        float lg = rbias;
#pragma unroll
        for (int p = 0; p < 8; ++p) lg += PART[(p * 16 + w + 8 * hu) * 32 + e_l];
        float tv[4]; int te[4];
        { const unsigned ub = __float_as_uint(lg); unsigned kh = ub ^ ((ub >> 31) ? 0xffffffffu : 0x80000000u), kl = 31u - (unsigned)e_l;
#pragma unroll
          for (int k4 = 0; k4 < 4; ++k4) {
            unsigned bh = kh, bl = kl;
#define R9_STEP(OH, OL) do { const unsigned oh = (unsigned)(OH), ol = (unsigned)(OL); const bool take = (((unsigned long long)oh << 32) | ol) > (((unsigned long long)bh << 32) | bl); bh = take ? oh : bh; bl = take ? ol : bl; } while (0)
            R9_STEP(dppi<0xB1>((int)bh), dppi<0xB1>((int)bl)); R9_STEP(dppi<0x4E>((int)bh), dppi<0x4E>((int)bl)); R9_STEP(dppi<0x141>((int)bh), dppi<0x141>((int)bl)); R9_STEP(dppi<0x140>((int)bh), dppi<0x140>((int)bl));
            R9_STEP(__shfl_xor((int)bh, 16), __shfl_xor((int)bl, 16));
#undef R9_STEP
            const unsigned vb = bh ^ ((bh >> 31) ? 0x80000000u : 0xffffffffu);
            tv[k4] = __uint_as_float(vb); te[k4] = 31 - (int)bl; if (kl == bl) kh = 0u;
          } }
        {
            const bool act_ = hu ? has2 : hasA; const int tok = hu ? tB : tA;
            const float p1 = __expf(tv[1] - tv[0]), p2 = __expf(tv[2] - tv[0]), p3 = __expf(tv[3] - tv[0]); const float inv = 1.0f / (1.0f + p1 + p2 + p3);
            if (e_l < 4 && act_) { const int e = e_l == 0 ? te[0] : e_l == 1 ? te[1] : e_l == 2 ? te[2] : te[3];
                const float gt = (e_l == 0 ? 1.0f : e_l == 1 ? p1 : e_l == 2 ? p2 : p3) * inv;
                const int rank = __hip_atomic_fetch_add(HIST + e, 1, __ATOMIC_RELAXED, __HIP_MEMORY_SCOPE_WORKGROUP);
                ALIST[((n + hu) * 8 + w) * 4 + e_l] = (unsigned)e | ((unsigned)rank << 8);
                TE[tok * 4 + e_l] = e; TG[tok * 4 + e_l] = gt; }
        }
    }
#undef R9_XLOAD
    __syncthreads();
    if (F.tid < 32) BASE[F.tid] = (int)__hip_atomic_fetch_add(cnt + 64 * F.tid, (unsigned)HIST[F.tid], __ATOMIC_RELAXED, __HIP_MEMORY_SCOPE_AGENT);
    __syncthreads();
    n = 0;
    for (int t = t0 + w; t < t1; t += 8, ++n) {
        if (lane < 4) { const unsigned ent = ALIST[(n * 8 + w) * 4 + lane]; const int e = (int)(ent & 255u), pos = BASE[e] + (int)(ent >> 8);
            LIST[(size_t)e * TL + pos] = t; TP[t * 4 + lane] = pos; SCL[(size_t)e * TL + pos] = TSC[n * 8 + w]; }
    }
    __syncthreads();
}
__device__ __forceinline__ void moe_tables(const Frame& F, volatile LAS int* tab) {
    if (F.tid < 64) {
        const unsigned* cnt = (const unsigned*)(F.ws + WS_CTL) + CW_CNT; const int e = F.tid & 31;
        const int n = (int)__hip_atomic_load(cnt + 64 * e, __ATOMIC_RELAXED, __HIP_MEMORY_SCOPE_AGENT);
        const int t = (n + 255) >> 8; int run = t;
#pragma unroll
        for (int o = 1; o < 32; o <<= 1) { const int v = __shfl_up(run, o); if (e >= o) run += v; }
        if (F.tid < 32) { tab[e] = run - t; tab[64 + e] = n; if (e == 31) tab[32] = run; }
    }
    __syncthreads();
}
__device__ __forceinline__ void p12_final(const Frame& F, volatile LAS int* tab) {
    const int gw = F.vcu * NWAVES + F.wave, NGW = F.G * NWAVES, lane = F.lane;
    const bf16* X1 = (const bf16*)(F.ws + WS_X1); const float* mod = (const float*)(F.ws + WS_MOD); const bf16* Y = (const bf16*)(F.ws + WS_Y);
    const int* TE = (const int*)(F.ws + WS_ROUTE); const int* TP = TE + TL * 4; const float* TG = (const float*)(TP + TL * 4);
    const float* fg = F.in[I_FG];
    const bf16* YP = (const bf16*)(F.ws + WS_YP);
    int Lfull, nlft, Sp; { const int U = tab[32] * 4; Lfull = (U / F.G) * F.G; nlft = U - Lfull; Sp = (nlft > 0 && nlft * 4 <= F.G) ? 4 : (nlft > 0 && nlft * 2 <= F.G) ? 2 : 1; }
    int emin = 32;
    if (Sp > 1) { const unsigned long long bm = __ballot(lane < 32 && tab[(lane & 31) + 1] * 4 > Lfull); emin = __builtin_amdgcn_readfirstlane((int)__builtin_ctzll(bm | (1ull << 32))); }
    f32x4 fgv[4];
#pragma unroll
    for (int j = 0; j < 4; ++j) fgv[j] = *(const f32x4*)(fg + 4 * lane + 256 * j);
    for (int tb = gw; tb < TL; tb += 2 * NGW) {
        const bool has2 = tb + NGW < TL;
        const int tt[2] = {tb, has2 ? tb + NGW : tb};
        size_t yoff[2][4]; float gt[2][4]; int ee[2][4], pp[2][4];
#pragma unroll
        for (int u = 0; u < 2; ++u)
#pragma unroll
            for (int k4 = 0; k4 < 4; ++k4) { const int e = TE[tt[u] * 4 + k4], pos = TP[tt[u] * 4 + k4]; gt[u][k4] = TG[tt[u] * 4 + k4]; yoff[u][k4] = ((size_t)tab[e] * 256 + pos) * D + 4 * lane; ee[u][k4] = e; pp[u][k4] = pos; }
        f32x4 xa[2][4], gm[2][4]; u32x2 yv[2][4][4];
#pragma unroll
        for (int u = 0; u < 2; ++u) { const float* mv = mod + (size_t)(tt[u] >> 11) * NMOD + 5 * D;
#pragma unroll
            for (int j = 0; j < 4; ++j) { const u32x2 xb = *(const u32x2*)(X1 + (size_t)tt[u] * D + 4 * lane + 256 * j); xa[u][j] = (f32x4){bflo(xb.x), bfhi(xb.x), bflo(xb.y), bfhi(xb.y)}; gm[u][j] = *(const f32x4*)(mv + 4 * lane + 256 * j);
#pragma unroll
                for (int k4 = 0; k4 < 4; ++k4) yv[u][k4][j] = *(const u32x2*)(Y + yoff[u][k4] + 256 * j); } }
        f32x4 ex[2][4];
#pragma unroll
        for (int u = 0; u < 2; ++u)
#pragma unroll
            for (int j = 0; j < 4; ++j) ex[u][j] = (f32x4){0.f, 0.f, 0.f, 0.f};
        if (Sp > 1) {
#pragma unroll
            for (int u = 0; u < 2; ++u)
#pragma unroll
                for (int k4 = 0; k4 < 4; ++k4) { const int e = __builtin_amdgcn_readfirstlane(ee[u][k4]);
                    if (e >= emin) { const int pos = __builtin_amdgcn_readfirstlane(pp[u][k4]);
                        const int tp0 = tab[e], tiles = tab[e + 1] - tp0, L0 = tp0 * 4 + (pos >> 8), L3 = L0 + 3 * tiles;
                        if (L3 >= Lfull) {
                            const bf16* yp = YP + (size_t)(pos & 255) * 256 + 4 * lane; const float g = gt[u][k4];
                            u32x2 yy[4][3]; float wj[4];
#pragma unroll
                            for (int j = 0; j < 4; ++j) { const int Lj = L0 + j * tiles; const bool ok = Lj >= Lfull; wj[j] = ok ? g : 0.f;
                                const bf16* yq = yp + (size_t)((ok ? Lj : L3) - Lfull) * 65536;
#pragma unroll
                                for (int p = 0; p < 3; ++p) yy[j][p] = *(const u32x2*)(yq + (size_t)((p + 1 < Sp) ? p : 0) * 256 * 65536); }
#pragma unroll
                            for (int j = 0; j < 4; ++j)
#pragma unroll
                                for (int p = 0; p < 3; ++p) { const float wv = (p + 1 < Sp) ? wj[j] : 0.f; const u32x2 y = yy[j][p];
                                    ex[u][j] += (f32x4){bflo(y.x), bfhi(y.x), bflo(y.y), bfhi(y.y)} * wv; } } } }
        }
#pragma unroll
        for (int u = 0; u < 2; ++u) {
            f32x4 xv[4]; float ss = 0.f;
#pragma unroll
            for (int j = 0; j < 4; ++j) { f32x4 m = (f32x4){0.f, 0.f, 0.f, 0.f};
#pragma unroll
                for (int k4 = 0; k4 < 4; ++k4) { const u32x2 y = yv[u][k4][j]; const float g = gt[u][k4]; m += (f32x4){bflo(y.x), bfhi(y.x), bflo(y.y), bfhi(y.y)} * g; }
                xv[j] = xa[u][j] + gm[u][j] * (m + ex[u][j]); ss += (xv[j][0] * xv[j][0] + xv[j][1] * xv[j][1]) + (xv[j][2] * xv[j][2] + xv[j][3] * xv[j][3]); }
            const float rstd = 1.0f / sqrtf(wave_sum(ss) * (1.0f / D) + EPS);
            if (u == 0 || has2) {
#pragma unroll
                for (int j = 0; j < 4; ++j) *(f32x4*)(F.out + (size_t)tt[u] * D + 4 * lane + 256 * j) = xv[j] * rstd * fgv[j]; }
        }
    }
}
__global__ void __launch_bounds__(NWAVES * 64, 2) fwd(Args args) {
    extern __shared__ __attribute__((aligned(16))) unsigned char lds[];
    Frame F;
    F.lds = (LAS unsigned char*)lds; F.tid = threadIdx.x; F.lane = F.tid & 63; F.wave = __builtin_amdgcn_readfirstlane(F.tid >> 6);
    F.G = gridDim.x; { const int bx = blockIdx.x; F.vcu = (F.G % 8 == 0) ? (bx % 8) * (F.G / 8) + bx / 8 : bx; }
    F.ws = args.ws; F.in = args.in; F.out = args.out;
    volatile LAS unsigned* MISC = (volatile LAS unsigned*)(F.lds + LDS_MISC);
    volatile LAS int* TAB = (volatile LAS int*)(F.lds + LDS_MISC + 64);
    for (int u = F.tid; u < (LDS_BYTES - LDS_MISC) / 4; u += NWAVES * 64) MISC[u] = 0u;
    __syncthreads();
    unsigned* ctl = (unsigned*)(F.ws + WS_CTL);
    XcdBarrier bar; bar.bar = ctl + CW_BAR; bar.x = 0; bar.st = nullptr;
    if (MK_N_LAUNCHES == 1) bar = xcd_barrier_post(ctl + CW_BAR, MISC);
#define GRID_BAR() do { if (MK_N_LAUNCHES == 1) xcd_barrier(bar); } while (0)
    const int lo = args.ph_lo, hi = args.ph_hi;
#ifndef PH_MASK
#define PH_MASK 0x1fff
#endif
#define IN(k) (((PH_MASK >> (k)) & 1) && lo <= (k) && (k) < hi)
#define BOTH(k) (IN(k) && IN((k) + 1))
    const int cid = (int)blockIdx.x;

#ifndef DUP_MASK
#define DUP_MASK 0
#endif
#define REPS(k) ((((DUP_MASK) >> (k)) & 1) ? 2 : 1)
#define REP_LOOP(k) _Pragma("unroll") for (int rep_ = 0; rep_ < REPS(k); ++rep_)
#define REP_SEP(k) do { if (rep_ + 1 < REPS(k)) { GRID_BAR(); if ((k) == 9) { if (blockIdx.x == 0 && F.tid < 32) __hip_atomic_store(ctl + CW_CNT + 64 * F.tid, 0u, __ATOMIC_RELAXED, __HIP_MEMORY_SCOPE_AGENT); GRID_BAR(); } } } while (0)
    if (IN(0)) { REP_LOOP(0) { p0_prologue(F); REP_SEP(0); } if (BOTH(0)) GRID_BAR(); }
    if (IN(1)) { REP_LOOP(1) { p1_norm(F); REP_SEP(1); } if (BOTH(1)) GRID_BAR(); }
    if (IN(2)) {
        SchedInproj S{(const char*)(F.ws + WS_H), (const char*)(F.ws + WS_WIN), F.G, cid};
        EpiInproj E{(bf16*)(F.ws + WS_P), (const float*)(F.ws + WS_HS), (const float*)(F.ws + WS_WINS)};
        SchedCached<SchedInproj> SC{S, F.lds}; SC.init(F.tid);
        REP_LOOP(2) { pg8::gemm_phase<EpiInproj, SchedCached<SchedInproj>, true, true>(F.lds, D, SC, E); REP_SEP(2); }
        if (F.G != 256) {
            LAS float* scr = (LAS float*)(F.lds + F.wave * 16384);
            const int FW = (F.G < 256 ? F.G : 256) * NWAVES;
            for (int it = 36 * FW + F.vcu * NWAVES + F.wave; it < MOE_ITEMS; it += F.G * NWAVES) { const MoeItem m = moe_item(F, it); float tv[16]; moe_conv_issue(m, F.lane, tv); moe_conv_finish(m, F.lane, tv, scr); }
            __syncthreads();
        }
        if (F.G == 256 && cid >= 128) {
            __syncthreads();
            moe_fill_dma(F, P2F_LO + (cid - 128) * NWAVES + F.wave, 128 * NWAVES, MOE_ITEMS);
            __syncthreads();
        }
        if (BOTH(2)) GRID_BAR();
    }
    if (IN(3)) { REP_LOOP(3) { lru_pass1(F, F.vcu, F.G); REP_SEP(3); } if (BOTH(3)) GRID_BAR(); }
    if (IN(4)) { REP_LOOP(13) { hgrn_phase(F); REP_SEP(13); } REP_LOOP(14) { lru_pass2_stream(F, F.vcu, F.G); REP_SEP(14); } if (BOTH(4)) GRID_BAR(); }
    if (IN(5)) {
        SchedSq S{(const char*)(F.ws + WS_A1), (const char*)(F.ws + WS_WBA), F.G, cid};
        EpiMerge<0> E{(bf16*)(F.ws + WS_T1), (const bf16*)(F.ws + WS_P) + 7 * PG_STRIDE, nullptr};
        REP_LOOP(6) { pg8::gemm_phase<EpiMerge<0>, SchedSq, false>(F.lds, D, S, E); REP_SEP(6); }
    }
    if (IN(6)) { REP_LOOP(5) { p5_readout(F); REP_SEP(5); } if (BOTH(6)) GRID_BAR(); }
    if (IN(7)) {
        SchedSq S{(const char*)(F.ws + WS_A2), (const char*)(F.ws + WS_WBB), F.G, cid};
        EpiMerge<1> E{(bf16*)(F.ws + WS_MM), (const bf16*)(F.ws + WS_P) + 8 * PG_STRIDE, (const bf16*)(F.ws + WS_T1)};
        REP_LOOP(7) { pg8::gemm_phase<EpiMerge<1>, SchedSq, false>(F.lds, D, S, E); REP_SEP(7); }
        if (BOTH(7)) GRID_BAR();
    }
    if (IN(8)) {
        SchedSq S{(const char*)(F.ws + WS_MM), (const char*)(F.ws + WS_WOUT), F.G, cid};
        EpiX1 E{(bf16*)(F.ws + WS_X1), F.in[I_X], (const float*)(F.ws + WS_MOD)};
        REP_LOOP(8) { pg8::gemm_phase<EpiX1, SchedSq, false>(F.lds, D, S, E); REP_SEP(8); }
        if (BOTH(8)) GRID_BAR();
    }
    if (IN(9)) { REP_LOOP(9) { p9_route(F); REP_SEP(9); } if (BOTH(9)) GRID_BAR(); }
    if (IN(10)) {
        moe_tables(F, TAB);
        SchedMoe<8, true> S{(const char*)(F.ws + WS_H2), (const char*)(F.ws + WS_W1), (const int*)(F.ws + WS_LIST), TAB, F.G, F.vcu, D};
        EpiAct E{(bf16*)(F.ws + WS_ACT), F.in[I_B1], (const float*)(F.ws + WS_SCL), (const float*)(F.ws + WS_SW1)};
        REP_LOOP(10) { pg8::gemm_phase<EpiAct, SchedMoe<8, true>, true, true>(F.lds, D, S, E); REP_SEP(10); }
        if (F.G == 256) {
            const int r10 = (TAB[32] * 8) % F.G, nidle = r10 > 0 ? F.G - r10 : F.G, rank = r10 > 0 ? F.vcu - r10 : F.vcu;
            if (rank >= 0) { __syncthreads(); moe_fill_dma(F, P10T_LO + rank * NWAVES + F.wave, nidle * NWAVES, P10T_HI); }
        }
        if (BOTH(10)) GRID_BAR();
    }
    if (IN(11)) {
        if (MK_N_LAUNCHES != 1 || !IN(10)) moe_tables(F, TAB);
        SchedDown S{(const char*)(F.ws + WS_ACT), (const char*)(F.ws + WS_W2), TAB, F.G, F.vcu, 2 * D};
        EpiY E{(bf16*)(F.ws + WS_Y), F.in[I_B2], (bf16*)(F.ws + WS_YP)};
        REP_LOOP(11) { pg8::gemm_phase<EpiY, SchedDown, true>(F.lds, D, S, E); REP_SEP(11); }
        if (BOTH(11)) GRID_BAR();
    }
    if (IN(12)) { if (MK_N_LAUNCHES != 1 || !IN(10)) moe_tables(F, TAB); REP_LOOP(12) { p12_final(F, TAB); REP_SEP(12); } }
#undef IN
#undef BOTH
#undef GRID_BAR
}

extern "C" void kernel_launch(void* const* d_in, const int* in_sizes, int n_in, void* d_out, int out_size, void* d_ws, size_t ws_size, hipStream_t stream) {
    static int grid = 0;
    if (grid == 0) {
        if (n_in != 28 || in_sizes[0] != TL * D || out_size != TL * D || ws_size < WS_END) { fprintf(stderr, "kernel_launch: unexpected shapes (n_in %d, in0 %d, out %d, ws %zu)\n", n_in, n_in > 0 ? in_sizes[0] : -1, out_size, ws_size); grid = -1; return; }
        int dev = 0, cus = 0, per_cu = 0;
        if (hipGetDevice(&dev) != hipSuccess || hipDeviceGetAttribute(&cus, hipDeviceAttributeMultiprocessorCount, dev) != hipSuccess) { grid = -1; return; }
        if (hipFuncSetAttribute((const void*)fwd, hipFuncAttributeMaxDynamicSharedMemorySize, LDS_BYTES) != hipSuccess) { fprintf(stderr, "kernel_launch: hipFuncSetAttribute failed\n"); grid = -1; return; }
        if (hipOccupancyMaxActiveBlocksPerMultiprocessor(&per_cu, (const void*)fwd, NWAVES * 64, LDS_BYTES) != hipSuccess || per_cu < 1) { fprintf(stderr, "kernel_launch: occupancy query reports %d\n", per_cu); }
        (void)hipGetLastError();
        grid = cus;
    }
    if (grid < 0) return;
    if (hipMemsetAsync((char*)d_ws + WS_CTL, 0, CTL_ZERO_BYTES, stream) != hipSuccess) return;
    Args a{};
    for (int i = 0; i < 28; ++i) a.in[i] = (const float*)d_in[i];
    a.out = (float*)d_out; a.ws = (unsigned char*)d_ws;
    if (MK_N_LAUNCHES == 1) {
        a.ph_lo = 0; a.ph_hi = NPH;
        hipLaunchKernelGGL(fwd, dim3(grid), dim3(NWAVES * 64), LDS_BYTES, stream, a);
    } else {
        for (int p = 0; p < NPH; ++p) { a.ph_lo = p; a.ph_hi = p + 1; hipLaunchKernelGGL(fwd, dim3(grid), dim3(NWAVES * 64), LDS_BYTES, stream, a); }
    }
}
```
